# Optimizing an MI355X kernel written in HIP

```python
import jax, jax.numpy as jnp
from jax import lax
import numpy as np

D_MODEL = 1024
BATCH = 8
SEQ = 2048
DEPTH = 2

CTX_LEN = 256
GRID_W = 64
EPS = 1e-6
NEG_INF = -1e30
ROPE_THETA = 10000.0
D_FF = ((8 * D_MODEL // 3) + 127) // 128 * 128
D_MIX = D_MODEL

A_W = D_MIX // 4
A_VDIM = 64
A_HEADS = A_W // A_VDIM
A_DIM = A_VDIM // 2
A_QK = A_HEADS * 2 * A_DIM
A_QBLOCK = 128
B_W = 3 * D_MIX // 8
B_DIM = 64
B_HEADS = B_W // B_DIM
B_KV_HEADS = B_HEADS // 3
B_WINDOW = 128
B_BLOCK = 128
C_W = D_MIX - A_W - B_W
C_DK = 64
C_DV = 64
C_HEADS = C_W // C_DV
C_CONV = 5
C_CHUNK = 64

IN_SIZES = (A_QK, A_QK, A_W, B_HEADS * B_DIM, B_KV_HEADS * B_DIM, B_KV_HEADS * B_DIM,
            3 * C_W, C_W, 2 * C_HEADS, 2 * C_HEADS)
IN_OFFSETS = tuple(sum(IN_SIZES[:i + 1]) for i in range(len(IN_SIZES) - 1))
IN_COLS = sum(IN_SIZES)

kernel_name = 'hybrid_diffusion_headgroup_trunk'

f32 = jnp.float32


def rms_norm(x, w=None):
    xf = x.astype(f32)
    y = xf * lax.rsqrt(jnp.mean(xf * xf, axis=-1, keepdims=True) + EPS)
    if w is not None:
        y = y * w.astype(f32)
    return y.astype(x.dtype)


def l2norm(x):
    return x * lax.rsqrt(jnp.sum(x * x, axis=-1, keepdims=True) + EPS)


def modulate(h, mod, i):
    return rms_norm(h) * (1.0 + mod[:, :, i + 1]) + mod[:, :, i]


def swiglu(x, w1, w2):
    gate, up = jnp.split(x @ w1, 2, axis=-1)
    return (jax.nn.silu(gate) * up) @ w2


def ffn_half_step(h, mod, i, w1, w2):
    return h + 0.5 * mod[:, :, i + 2] * swiglu(modulate(h, mod, i), w1, w2)


def apply_rope_2d(x):
    n, d = x.shape[1], x.shape[-1]
    rows = n // GRID_W
    row = jnp.repeat(jnp.arange(rows, dtype=f32), GRID_W)
    col = jnp.tile(jnp.arange(GRID_W, dtype=f32), rows)
    half = d // 2
    inv = ROPE_THETA ** (-jnp.arange(0, half, 2, dtype=f32) / half)
    bshape = (n,) + (1,) * (x.ndim - 3) + (half // 2,)

    def rot(xa, pos):
        ang = (pos[:, None] * inv).reshape(bshape)
        cs, sn = jnp.cos(ang), jnp.sin(ang)
        x1, x2 = xa[..., :half // 2], xa[..., half // 2:]
        return jnp.concatenate([x1 * cs - x2 * sn, x2 * cs + x1 * sn], axis=-1)

    xf = x.astype(f32)
    out = jnp.concatenate([rot(xf[..., :half], row), rot(xf[..., half:], col)], axis=-1)
    return out.astype(x.dtype)


def diff_attention(q, k, v, lam):
    s = jnp.einsum('bqhmd,bkhmd->bhmqk', q, k).astype(f32) * (A_DIM ** -0.5)
    p = jax.nn.softmax(s, axis=-1)
    w = (p[:, :, 0] - lam * p[:, :, 1]).astype(v.dtype)
    return jnp.einsum('bhqk,bkhd->bqhd', w, v)


def diff_attention_blocked(q, k, v, lam):
    bn, n = q.shape[:2]
    nb = n // A_QBLOCK
    qb = jnp.moveaxis(q.reshape((bn, nb, A_QBLOCK) + q.shape[2:]), 1, 0)
    ob = lax.map(lambda qq: diff_attention(qq, k, v, lam), qb)
    return jnp.moveaxis(ob, 0, 1).reshape((bn, n) + ob.shape[3:])


def window_sink_attention_latent(q, k, v, k_ctx, v_ctx, sink):
    bn, n = q.shape[:2]
    nb = n // B_BLOCK
    G = B_HEADS // B_KV_HEADS
    L = B_BLOCK
    qb = q.reshape(bn, nb, L, B_KV_HEADS, G, B_DIM)

    def band(t):
        tb = t.reshape(bn, nb, L, B_KV_HEADS, B_DIM)
        tp = jnp.pad(tb, ((0, 0), (1, 1), (0, 0), (0, 0), (0, 0)))
        return jnp.concatenate([tp[:, :-2], tp[:, 1:-1], tp[:, 2:]], axis=2)

    kb, vb = band(k), band(v)
    qpos = jnp.arange(n).reshape(nb, L)
    kpos = (jnp.arange(nb)[:, None] - 1) * L + jnp.arange(3 * L)[None, :]
    valid = ((kpos >= 0) & (kpos < n))[:, None, :] & (jnp.abs(qpos[:, :, None] - kpos[:, None, :]) <= B_WINDOW)
    scale = B_DIM ** -0.5
    s_band = jnp.einsum('bnqhgd,bnkhd->bnhgqk', qb, kb).astype(f32) * scale
    s_band = jnp.where(valid[None, :, None, None], s_band, NEG_INF)
    s_ctx = jnp.einsum('bnqhgd,bkhd->bnhgqk', qb, k_ctx).astype(f32) * scale
    s_sink = jnp.broadcast_to(sink.astype(f32).reshape(1, 1, B_KV_HEADS, G, 1, 1), s_ctx.shape[:-1] + (1,))
    p = jax.nn.softmax(jnp.concatenate([s_sink, s_ctx, s_band], axis=-1), axis=-1)
    m = k_ctx.shape[1]
    p_ctx = p[..., 1:1 + m].astype(v.dtype)
    p_band = p[..., 1 + m:].astype(v.dtype)
    o = (jnp.einsum('bnhgqk,bkhd->bnqhgd', p_ctx, v_ctx)
         + jnp.einsum('bnhgqk,bnkhd->bnqhgd', p_band, vb))
    return o.reshape(bn, n, B_HEADS * B_DIM)


def sink_attention_context(q, k, v, sink):
    bn, m = q.shape[:2]
    G = B_HEADS // B_KV_HEADS
    qg = q.reshape(bn, m, B_KV_HEADS, G, B_DIM)
    s = jnp.einsum('bqhgd,bkhd->bhgqk', qg, k).astype(f32) * (B_DIM ** -0.5)
    s_sink = jnp.broadcast_to(sink.astype(f32).reshape(1, B_KV_HEADS, G, 1, 1), s.shape[:-1] + (1,))
    p = jax.nn.softmax(jnp.concatenate([s_sink, s], axis=-1), axis=-1)[..., 1:]
    o = jnp.einsum('bhgqk,bkhd->bqhgd', p.astype(v.dtype), v)
    return o.reshape(bn, m, B_HEADS * B_DIM)


def short_conv(x, w):
    return lax.conv_general_dilated(x, w[:, None, :].astype(x.dtype), window_strides=(1,), padding='SAME',
                                    dimension_numbers=('NWC', 'WIO', 'NWC'), feature_group_count=x.shape[-1])


def gdn_chunk_scan(q, k, v, g, beta, s0):
    bn, T, H, _ = q.shape
    dv = v.shape[-1]
    L = C_CHUNK
    nc = T // L

    def chunk(t):
        return jnp.swapaxes(t.reshape((bn, nc, L) + t.shape[2:]), 2, 3)

    q, k, v, g, beta = chunk(q), chunk(k), chunk(v), chunk(g), chunk(beta)
    Gc = jnp.cumsum(g, axis=-1)
    incl = jnp.tril(jnp.ones((L, L), bool))
    strict = jnp.tril(jnp.ones((L, L), bool), -1)
    decay = jnp.exp(jnp.where(incl, Gc[..., :, None] - Gc[..., None, :], NEG_INF))
    kk = jnp.einsum('bchid,bchjd->bchij', k, k)
    A = jnp.where(strict, beta[..., :, None] * kk * decay, 0.0)
    eye = jnp.eye(L, dtype=f32)
    Tm = lax.linalg.triangular_solve(A + eye, jnp.broadcast_to(eye, A.shape), left_side=True, lower=True)
    eG = jnp.exp(Gc)[..., None]
    u = Tm @ (beta[..., None] * v)
    w = Tm @ (beta[..., None] * eG * k)
    qk = jnp.where(incl, jnp.einsum('bchid,bchjd->bchij', q, k) * decay, 0.0)
    q_dec = q * eG
    k_dec = k * jnp.exp(Gc[..., -1:] - Gc)[..., None]
    g_last = jnp.exp(Gc[..., -1])
    xs = tuple(jnp.moveaxis(t, 1, 0) for t in (u, w, qk, q_dec, k_dec, g_last))

    def step(S, inp):
        u_c, w_c, qk_c, qd_c, kd_c, gl_c = inp
        v_new = u_c - w_c @ S
        o_c = qd_c @ S + qk_c @ v_new
        S = S * gl_c[..., None, None] + jnp.einsum('bhld,bhle->bhde', kd_c, v_new)
        return S, o_c

    s_fin, o = lax.scan(step, s0, xs)
    o = jnp.transpose(o, (1, 0, 3, 2, 4)).reshape(bn, T, H, dv)
    return o, s_fin


def gdn_inputs(p, conv_w):
    bn, T = p[6].shape[:2]
    qkv = jax.nn.silu(short_conv(p[6], conv_w)).astype(f32)
    q, k, v = jnp.split(qkv, 3, axis=-1)
    q = l2norm(q.reshape(bn, T, C_HEADS, C_DK)) * (C_DK ** -0.5)
    k = l2norm(k.reshape(bn, T, C_HEADS, C_DK))
    v = v.reshape(bn, T, C_HEADS, C_DV)
    a = p[8].astype(f32).reshape(bn, T, 2, C_HEADS)
    b = p[9].astype(f32).reshape(bn, T, 2, C_HEADS)
    return q, k, v, a, b


def gdn_bidirectional(ctx_in, lat_in, A_log, dt_bias):
    qc, kc, vc, ac, bc = ctx_in
    ql, kl, vl, al, bl = lat_in
    bn = ql.shape[0]
    o_c = 0.0
    o_l = 0.0
    for d in range(2):
        fl = (lambda t: t[:, ::-1]) if d == 1 else (lambda t: t)
        a_rate = jnp.exp(A_log[d].astype(f32))
        dtb = dt_bias[d].astype(f32)
        gc = -a_rate * jax.nn.softplus(ac[:, :, d] + dtb)
        gl = -a_rate * jax.nn.softplus(al[:, :, d] + dtb)
        s0 = jnp.zeros((bn, C_HEADS, C_DK, C_DV), f32)
        oc, s_ctx = gdn_chunk_scan(fl(qc), fl(kc), fl(vc), fl(gc), fl(jax.nn.sigmoid(bc[:, :, d])), s0)
        ol, _ = gdn_chunk_scan(fl(ql), fl(kl), fl(vl), fl(gl), fl(jax.nn.sigmoid(bl[:, :, d])), s_ctx)
        o_c = o_c + fl(oc)
        o_l = o_l + fl(ol)
    return o_c, o_l


def hybrid_mixer(hn_ctx, hn_lat, w_in, w_out, a_qnorm, a_knorm, a_lambda, a_subln, lam_init,
                 b_qnorm, b_knorm, b_sink, c_conv, c_A_log, c_dt_bias, c_onorm, need_ctx):
    dt = hn_lat.dtype
    bn, n = hn_lat.shape[:2]
    m = hn_ctx.shape[1]
    pl = jnp.split(hn_lat @ w_in, IN_OFFSETS, axis=-1)
    pc = jnp.split(hn_ctx @ w_in, IN_OFFSETS, axis=-1)

    def a_heads(t, w):
        return rms_norm(t.reshape(t.shape[:2] + (A_HEADS, 2, A_DIM)), w)

    qa_l = apply_rope_2d(a_heads(pl[0], a_qnorm))
    ka_l = apply_rope_2d(a_heads(pl[1], a_knorm))
    qa_c = a_heads(pc[0], a_qnorm)
    ka_c = a_heads(pc[1], a_knorm)
    va_l = pl[2].reshape(bn, n, A_HEADS, A_VDIM)
    va_c = pc[2].reshape(bn, m, A_HEADS, A_VDIM)
    lf = a_lambda.astype(f32)
    lam = jnp.exp(jnp.sum(lf[0] * lf[1])) - jnp.exp(jnp.sum(lf[2] * lf[3])) + lam_init

    def a_out(o):
        return (rms_norm(o, a_subln) * (1.0 - lam_init)).reshape(o.shape[:2] + (A_W,)).astype(dt)

    ya_l = a_out(diff_attention_blocked(qa_l, jnp.concatenate([ka_c, ka_l], axis=1),
                                        jnp.concatenate([va_c, va_l], axis=1), lam))

    qb_l = apply_rope_2d(rms_norm(pl[3].reshape(bn, n, B_HEADS, B_DIM), b_qnorm))
    kb_l = apply_rope_2d(rms_norm(pl[4].reshape(bn, n, B_KV_HEADS, B_DIM), b_knorm))
    vb_l = pl[5].reshape(bn, n, B_KV_HEADS, B_DIM)
    kb_c = rms_norm(pc[4].reshape(bn, m, B_KV_HEADS, B_DIM), b_knorm)
    vb_c = pc[5].reshape(bn, m, B_KV_HEADS, B_DIM)
    yb_l = window_sink_attention_latent(qb_l, kb_l, vb_l, kb_c, vb_c, b_sink).astype(dt)

    oc_c, oc_l = gdn_bidirectional(gdn_inputs(pc, c_conv), gdn_inputs(pl, c_conv), c_A_log, c_dt_bias)

    def c_out(o, gate):
        gz = jax.nn.silu(gate.astype(f32).reshape(o.shape))
        return (rms_norm(o, c_onorm) * gz).reshape(o.shape[:2] + (C_W,)).astype(dt)

    yc_l = c_out(oc_l, pl[7])
    y_lat = jnp.concatenate([ya_l, yb_l, yc_l], axis=-1) @ w_out

    if not need_ctx:
        return None, y_lat
    ya_c = a_out(diff_attention(qa_c, ka_c, va_c, lam))
    qb_c = rms_norm(pc[3].reshape(bn, m, B_HEADS, B_DIM), b_qnorm)
    yb_c = sink_attention_context(qb_c, kb_c, vb_c, b_sink).astype(dt)
    yc_c = c_out(oc_c, pc[7])
    y_ctx = jnp.concatenate([ya_c, yb_c, yc_c], axis=-1) @ w_out
    return y_ctx, y_lat


def setup_inputs(seed: int = 0) -> dict:
    key = jax.random.key(seed)
    ks = jax.random.split(key, 24)
    D = D_MODEL

    def nrm(k, shape, scale):
        return jax.random.normal(k, shape, f32) * scale

    dt = jnp.exp(jax.random.uniform(ks[22], (DEPTH, 2, C_HEADS), f32, np.log(1e-3), np.log(1e-1)))
    return {
        'x': nrm(ks[0], (BATCH, SEQ, D), 1.0),
        'c': nrm(ks[1], (BATCH, D), 1.0),
        'ctx': nrm(ks[2], (BATCH, CTX_LEN, D), 1.0),
        'c_ctx': nrm(ks[3], (D,), 1.0),
        'w_mod': nrm(ks[4], (DEPTH, D, 9 * D), 0.5 * D ** -0.5),
        'b_mod': nrm(ks[5], (DEPTH, 9 * D), 0.02),
        'ffn1_w1': nrm(ks[6], (DEPTH, D, 2 * D_FF), D ** -0.5),
        'ffn1_w2': nrm(ks[7], (DEPTH, D_FF, D), D_FF ** -0.5),
        'ffn2_w1': nrm(ks[8], (DEPTH, D, 2 * D_FF), D ** -0.5),
        'ffn2_w2': nrm(ks[9], (DEPTH, D_FF, D), D_FF ** -0.5),
        'w_in': nrm(ks[10], (DEPTH, D, IN_COLS), D ** -0.5),
        'w_out': nrm(ks[11], (DEPTH, D_MIX, D), D_MIX ** -0.5),
        'a_qnorm': 1.0 + nrm(ks[12], (DEPTH, A_DIM), 0.02),
        'a_knorm': 1.0 + nrm(ks[13], (DEPTH, A_DIM), 0.02),
        'a_lambda': nrm(ks[14], (DEPTH, 4, A_DIM), 0.1),
        'a_subln': 1.0 + nrm(ks[15], (DEPTH, A_VDIM), 0.02),
        'b_qnorm': 1.0 + nrm(ks[16], (DEPTH, B_DIM), 0.02),
        'b_knorm': 1.0 + nrm(ks[17], (DEPTH, B_DIM), 0.02),
        'b_sink': nrm(ks[18], (DEPTH, B_HEADS), 0.5),
        'c_conv': nrm(ks[19], (DEPTH, C_CONV, 3 * C_W), C_CONV ** -0.5),
        'c_A_log': jnp.log(jax.random.uniform(ks[20], (DEPTH, 2, C_HEADS), f32, 1.0, 16.0)),
        'c_dt_bias': dt + jnp.log(-jnp.expm1(-dt)),
        'c_onorm': 1.0 + nrm(ks[21], (DEPTH, C_DV), 0.02),
    }


def reference(x, c, ctx, c_ctx, w_mod, b_mod, ffn1_w1, ffn1_w2, ffn2_w1, ffn2_w2, w_in, w_out,
              a_qnorm, a_knorm, a_lambda, a_subln, b_qnorm, b_knorm, b_sink,
              c_conv, c_A_log, c_dt_bias, c_onorm):
    h_lat, h_ctx = x, ctx
    silu_c = jax.nn.silu(c)
    silu_cc = jax.nn.silu(c_ctx)
    for l in range(DEPTH):
        last = l == DEPTH - 1
        lam_init = 0.8 - 0.6 * float(np.exp(-0.3 * l))
        mod_lat = (silu_c @ w_mod[l] + b_mod[l]).reshape(c.shape[0], 1, 9, D_MODEL)
        mod_ctx = (silu_cc @ w_mod[l] + b_mod[l]).reshape(1, 1, 9, D_MODEL)
        h_lat = ffn_half_step(h_lat, mod_lat, 0, ffn1_w1[l], ffn1_w2[l])
        h_ctx = ffn_half_step(h_ctx, mod_ctx, 0, ffn1_w1[l], ffn1_w2[l])
        y_ctx, y_lat = hybrid_mixer(modulate(h_ctx, mod_ctx, 3), modulate(h_lat, mod_lat, 3),
                                    w_in[l], w_out[l], a_qnorm[l], a_knorm[l], a_lambda[l], a_subln[l], lam_init,
                                    b_qnorm[l], b_knorm[l], b_sink[l], c_conv[l], c_A_log[l], c_dt_bias[l],
                                    c_onorm[l], not last)
        h_lat = h_lat + mod_lat[:, :, 5] * y_lat
        h_lat = ffn_half_step(h_lat, mod_lat, 6, ffn2_w1[l], ffn2_w2[l])
        if not last:
            h_ctx = h_ctx + mod_ctx[:, :, 5] * y_ctx
            h_ctx = ffn_half_step(h_ctx, mod_ctx, 6, ffn2_w1[l], ffn2_w2[l])
    return h_lat
```

```cpp
#include <hip/hip_runtime.h>
#include <hip/hip_cooperative_groups.h>
#include <cstdio>
#include <cstdint>
namespace cg = cooperative_groups;

typedef unsigned short bf16_t;
typedef short bf16x8 __attribute__((ext_vector_type(8)));
typedef short bf16x4 __attribute__((ext_vector_type(4)));
typedef float f32x4 __attribute__((ext_vector_type(4)));
typedef unsigned u32x2 __attribute__((ext_vector_type(2)));
typedef unsigned u32x4 __attribute__((ext_vector_type(4)));

constexpr int D = 1024, NB = 8, TL = 2048, TC = 256, TB = 2304, M = NB * TB;
constexpr int DFF = 2816, NIN = 2968, NINP = 3072;
constexpr int NREC = NB * 36 * 6 * 2;
constexpr float EPS = 1e-6f;
constexpr float LOG2E = 1.4426950408889634f;

constexpr size_t SZ_H = (size_t)M * D * 4;
constexpr size_t SZ_HN = (size_t)M * D * 2;
constexpr size_t SZ_BIG = (size_t)M * NINP * 2;
constexpr size_t E_W1 = (size_t)5632 * 1024, E_W2 = (size_t)1024 * 2816, E_WIN = (size_t)NINP * 1024, E_WOUT = (size_t)1024 * 1024;
constexpr size_t SZ_W = (2 * E_W1 + 2 * E_W2 + E_WIN + E_WOUT) * 2;
constexpr size_t SZ_QC = (size_t)M * 384 * 2;
constexpr size_t OFF_H = 0;
constexpr size_t OFF_HN = OFF_H + SZ_H;
constexpr size_t OFF_BIG = OFF_HN + SZ_HN;
constexpr size_t OFF_W = OFF_BIG + SZ_BIG;
constexpr size_t OFF_QC = OFF_W + SZ_W;
constexpr size_t OFF_KC = OFF_QC + SZ_QC;
constexpr size_t OFF_VC = OFF_KC + SZ_QC;
constexpr size_t OFF_MOD = OFF_VC + SZ_QC;
constexpr size_t OFF_G = OFF_MOD + (size_t)2 * 9 * 9216 * 4;
constexpr size_t OFF_BETA = OFF_G + (size_t)M * 12 * 4;
constexpr size_t OFF_EG = OFF_BETA + (size_t)M * 12 * 4;
constexpr size_t OFF_GL = OFF_EG + (size_t)NREC * 64 * 4;
constexpr size_t OFF_CTR = OFF_GL + (size_t)NREC * 4;
constexpr size_t OFF_BAR = OFF_CTR + 256;
constexpr size_t WS_NEED = OFF_BAR + 3456 * 4;
static_assert(SZ_BIG == (size_t)NREC * 32768, "record region");
constexpr size_t WO_W1A = 0, WO_W2A = WO_W1A + E_W1, WO_WIN = WO_W2A + E_W2, WO_WOUT = WO_WIN + E_WIN, WO_W1B = WO_WOUT + E_WOUT, WO_W2B = WO_W1B + E_W1;
constexpr size_t DO_QA = 0, DO_KA = DO_QA + (size_t)NB * 4 * 2 * TB * 32 * 2, DO_VAT = DO_KA + (size_t)NB * 4 * 2 * TB * 32 * 2,
                 DO_QB = DO_VAT + (size_t)NB * 4 * 64 * TB * 2, DO_KB = DO_QB + (size_t)NB * 6 * TB * 64 * 2, DO_VBT = DO_KB + (size_t)NB * 2 * TB * 64 * 2,
                 DO_END = DO_VBT + (size_t)NB * 2 * 64 * TB * 2;
static_assert(DO_END <= (size_t)NB * TL * D * 4, "d_out scratch");
static_assert((size_t)2 * M * 384 * 4 <= (size_t)NB * TL * D * 4, "O scratch");

struct Params {
    const float *x, *c, *ctx, *c_ctx, *w_mod, *b_mod, *ffn1_w1, *ffn1_w2, *ffn2_w1, *ffn2_w2, *w_in, *w_out;
    const float *a_qnorm, *a_knorm, *a_lambda, *a_subln, *b_qnorm, *b_knorm, *b_sink, *c_conv, *c_A_log, *c_dt_bias, *c_onorm;
    float* out;
    char* ws;
};

typedef __bf16 bf16v2_t __attribute__((ext_vector_type(2)));
typedef float f32x2_t __attribute__((ext_vector_type(2)));
__device__ __forceinline__ unsigned cvt_pk_bf16(float lo, float hi) { const f32x2_t v = {lo, hi}; const bf16v2_t r = __builtin_convertvector(v, bf16v2_t); return __builtin_bit_cast(unsigned, r); }
__device__ __forceinline__ bf16_t f2bf(float f) { return (bf16_t)(cvt_pk_bf16(f, 0.f) & 0xffffu); }
__device__ __forceinline__ float bf2f(bf16_t h) { return __uint_as_float(((unsigned)h) << 16); }
__device__ __forceinline__ float bflo(unsigned u) { return __uint_as_float(u << 16); }
__device__ __forceinline__ float bfhi(unsigned u) { return __uint_as_float(u & 0xffff0000u); }
__device__ __forceinline__ float siluf(float v) { return v / (1.f + __expf(-v)); }
__device__ __forceinline__ f32x4 mfma16(bf16x8 a, bf16x8 b, f32x4 c) { return __builtin_amdgcn_mfma_f32_16x16x32_bf16(a, b, c, 0, 0, 0); }
__device__ __forceinline__ bf16x8 pack8(f32x4 a, f32x4 b) {
    u32x4 r; r.x = cvt_pk_bf16(a[0], a[1]); r.y = cvt_pk_bf16(a[2], a[3]); r.z = cvt_pk_bf16(b[0], b[1]); r.w = cvt_pk_bf16(b[2], b[3]);
    return __builtin_bit_cast(bf16x8, r);
}
__device__ __forceinline__ bf16x8 ld8(const bf16_t* p) { return *(const bf16x8*)p; }
__device__ __forceinline__ bf16x8 ld44(const bf16_t* p0, const bf16_t* p1) {
    u32x2 a = *(const u32x2*)p0, b = *(const u32x2*)p1; u32x4 r; r.x = a.x; r.y = a.y; r.z = b.x; r.w = b.y; return __builtin_bit_cast(bf16x8, r);
}
__device__ __forceinline__ float wave_sum(float v) {
    v += __shfl_xor(v, 32); v += __shfl_xor(v, 16); v += __shfl_xor(v, 8); v += __shfl_xor(v, 4); v += __shfl_xor(v, 2); v += __shfl_xor(v, 1); return v;
}
__device__ __forceinline__ float half_sum(float v) {
    v += __shfl_xor(v, 16); v += __shfl_xor(v, 8); v += __shfl_xor(v, 4); v += __shfl_xor(v, 2); v += __shfl_xor(v, 1); return v;
}
__device__ __forceinline__ float wave_max(float v) {
    v = fmaxf(v, __shfl_xor(v, 32)); v = fmaxf(v, __shfl_xor(v, 16)); v = fmaxf(v, __shfl_xor(v, 8)); v = fmaxf(v, __shfl_xor(v, 4)); v = fmaxf(v, __shfl_xor(v, 2)); v = fmaxf(v, __shfl_xor(v, 1)); return v;
}

__device__ __forceinline__ int opaque_tid() { int t = threadIdx.x; asm volatile("" : "+v"(t)); return t; }

__device__ __forceinline__ void convert_tile(const float* W, int K, int N, bf16_t* Wt, int mode, int tile, char* lds) {
    float* T = (float*)lds;
    const int nkt = K >> 6, tk = tile % nkt, tn = tile / nkt, k0 = tk * 64, n0 = tn * 64, tid = opaque_tid();
    {
        const int nl = (tid & 15) * 4, np = n0 + nl;
        int src = np;
        if (mode == 1) { const int g = np >> 5, w = np & 31; src = (w < 16) ? g * 16 + w : DFF + g * 16 + (w - 16); }
        const bool ok = (mode == 1) ? true : (np < N);
#pragma unroll
        for (int i = 0; i < 4; ++i) {
            const int kl = (tid >> 4) + 16 * i;
            f32x4 v = (f32x4){0.f, 0.f, 0.f, 0.f};
            if (ok) v = *(const f32x4*)(W + (size_t)(k0 + kl) * N + src);
            T[kl * 65 + nl] = v[0]; T[kl * 65 + nl + 1] = v[1]; T[kl * 65 + nl + 2] = v[2]; T[kl * 65 + nl + 3] = v[3];
        }
    }
    __syncthreads();
    {
        const int kp = tid & 31;
#pragma unroll 4
        for (int i = 0; i < 8; ++i) { const int nl = (tid >> 5) + 8 * i; *(unsigned*)(Wt + (size_t)(n0 + nl) * K + k0 + 2 * kp) = cvt_pk_bf16(T[(2 * kp) * 65 + nl], T[(2 * kp + 1) * 65 + nl]); }
    }
    __syncthreads();
}

__device__ __forceinline__ void mod_tile(const Params& p, int item, char* lds) {
    float* sc = (float*)lds;
    const int tid = opaque_tid(), l = item / 144, c0 = (item % 144) * 64;
    for (int i = tid; i < 9 * 1024; i += 256) { const float v = (i < 8192) ? p.c[i] : p.c_ctx[i - 8192]; sc[i] = siluf(v); }
    __syncthreads();
    const int cgp = tid & 15, kg = tid >> 4;
    f32x4 acc[9];
#pragma unroll
    for (int r = 0; r < 9; ++r) acc[r] = (f32x4){0.f, 0.f, 0.f, 0.f};
    const float* Wp = p.w_mod + (size_t)l * 1024 * 9216 + c0 + cgp * 4;
#pragma unroll 4
    for (int kk = 0; kk < 64; ++kk) {
        const int k = kg * 64 + kk;
        const f32x4 w = *(const f32x4*)(Wp + (size_t)k * 9216);
#pragma unroll
        for (int r = 0; r < 9; ++r) acc[r] += w * sc[r * 1024 + k];
    }
    __syncthreads();
    float* red = (float*)lds;
#pragma unroll
    for (int r = 0; r < 9; ++r) *(f32x4*)(red + (kg * 9 + r) * 64 + cgp * 4) = acc[r];
    __syncthreads();
    float* MOD = (float*)(p.ws + OFF_MOD);
    for (int o = tid; o < 9 * 64; o += 256) {
        const int r = o >> 6, cc = o & 63; float s = 0.f;
#pragma unroll
        for (int g = 0; g < 16; ++g) s += red[(g * 9 + r) * 64 + cc];
        MOD[((size_t)l * 9 + r) * 9216 + c0 + cc] = s + p.b_mod[(size_t)l * 9216 + c0 + cc];
    }
    __syncthreads();
}

__device__ __forceinline__ void norm_phase(const Params& p, int layer, int midx, bool skip_ctx) {
    const float* H = (const float*)(p.ws + OFF_H);
    bf16_t* HN = (bf16_t*)(p.ws + OFF_HN);
    const float* MOD = (const float*)(p.ws + OFF_MOD) + (size_t)layer * 9 * 9216;
    const int tidn = opaque_tid();
    const int lane = tidn & 63, gw = blockIdx.x * 4 + (tidn >> 6), nw = gridDim.x * 4;
    for (int rbase = gw; rbase < M; rbase += 3 * nw) {
        f32x4 v[3][4]; float ss[3]; bool ok[3]; int mrr[3];
#pragma unroll
        for (int u = 0; u < 3; ++u) {
            const int row = rbase + u * nw;
            const int rr = row < M ? row : M - 1;
            const int b = rr / TB, t = rr - b * TB;
            ok[u] = (row < M) && !(skip_ctx && t < TC);
            mrr[u] = (t < TC) ? 8 : b;
            const float* xr = H + (size_t)rr * D;
            ss[u] = 0.f;
            if (ok[u]) {
#pragma unroll
                for (int i = 0; i < 4; ++i) { v[u][i] = *(const f32x4*)(xr + lane * 4 + i * 256); ss[u] += v[u][i][0] * v[u][i][0] + v[u][i][1] * v[u][i][1] + v[u][i][2] * v[u][i][2] + v[u][i][3] * v[u][i][3]; }
            }
        }
#pragma unroll
        for (int u = 0; u < 3; ++u) {
            if (!ok[u]) continue;
            const int row = rbase + u * nw;
            const float r = rsqrtf(wave_sum(ss[u]) * (1.f / 1024.f) + EPS);
            const float* sh = MOD + (size_t)mrr[u] * 9216 + midx * 1024, *scp = sh + 1024;
#pragma unroll
            for (int i = 0; i < 4; ++i) {
                const int col = lane * 4 + i * 256;
                const f32x4 s4 = *(const f32x4*)(sh + col), c4 = *(const f32x4*)(scp + col);
                u32x2 o; o.x = cvt_pk_bf16(v[u][i][0] * r * (1.f + c4[0]) + s4[0], v[u][i][1] * r * (1.f + c4[1]) + s4[1]);
                o.y = cvt_pk_bf16(v[u][i][2] * r * (1.f + c4[2]) + s4[2], v[u][i][3] * r * (1.f + c4[3]) + s4[3]);
                *(u32x2*)(HN + (size_t)row * D + col) = o;
            }
        }
    }
}

struct EpiArgs { bf16_t* obf; float* H; float* outp; const float* gate; float gscale; int ldo; };
template <int EPI>
__device__ __forceinline__ void gemm_phase(const bf16_t* A, const bf16_t* Bt, int K, int nN, bool skip_ctx, const EpiArgs e, char* lds) {
    const int tid = opaque_tid(), lane = tid & 63, w = tid >> 6, wm = w >> 1, wn = w & 1, l15 = lane & 15, quad = lane >> 4;
    const int ntm = skip_ctx ? 128 : 144, ntiles = ntm * nN, nk = K >> 6;
    const int woff = (tid >> 3) * 128 + ((((tid & 7) ^ ((tid >> 4) & 7))) << 4);
    int aoff[4][2], boff[4][2];
#pragma unroll
    for (int t = 0; t < 4; ++t)
#pragma unroll
        for (int ks = 0; ks < 2; ++ks) {
            aoff[t][ks] = (wm * 64 + t * 16 + l15) * 128 + ((((ks * 4 + quad) ^ (l15 >> 1))) << 4);
            boff[t][ks] = 16384 + (wn * 64 + t * 16 + l15) * 128 + ((((ks * 4 + quad) ^ (l15 >> 1))) << 4);
        }
    const int xcd = blockIdx.x & 7, lblk = blockIdx.x >> 3, nlb = gridDim.x >> 3, ntmx = ntm >> 3, ntx = ntmx * nN, nfull = (nN >> 3) << 3;
    (void)ntiles;
    for (int lt = lblk; lt < ntx; lt += nlb) {
        int tml, tn;
        if (lt < ntmx * nfull) { const int g = lt / (ntmx * 8), rem = lt - g * (ntmx * 8); tml = rem >> 3; tn = g * 8 + (rem & 7); }
        else { const int l2 = lt - ntmx * nfull, gw = nN - nfull; tml = l2 / gw; tn = nfull + (l2 - tml * gw); }
        const int tmi = xcd * ntmx + tml;
        const int tm = skip_ctx ? (tmi >> 4) * 18 + 2 + (tmi & 15) : tmi;
        const int m0 = tm * 128, n0 = tn * 128;
        const bf16_t* ag = A + (size_t)(m0 + (tid >> 3)) * K + (tid & 7) * 8;
        const bf16_t* bg = Bt + (size_t)(n0 + (tid >> 3)) * K + (tid & 7) * 8;
        f32x4 acc[4][4];
#pragma unroll
        for (int i = 0; i < 4; ++i)
#pragma unroll
            for (int j = 0; j < 4; ++j) acc[i][j] = (f32x4){0.f, 0.f, 0.f, 0.f};
        u32x4 ra0[4], rb0[4], ra1[4], rb1[4];
#define GLOAD(RA, RB, KT) do { _Pragma("unroll") for (int i = 0; i < 4; ++i) { RA[i] = *(const u32x4*)(ag + (size_t)i * 32 * K + (KT) * 64); RB[i] = *(const u32x4*)(bg + (size_t)i * 32 * K + (KT) * 64); } } while (0)
#define LSTORE(RA, RB, BUF) do { _Pragma("unroll") for (int i = 0; i < 4; ++i) { *(u32x4*)((BUF) + woff + i * 4096) = RA[i]; *(u32x4*)((BUF) + 16384 + woff + i * 4096) = RB[i]; } } while (0)
#define COMPUTE(BUF) do { _Pragma("unroll") for (int ks = 0; ks < 2; ++ks) { bf16x8 af[4], bfr[4]; \
            _Pragma("unroll") for (int t = 0; t < 4; ++t) { af[t] = *(const bf16x8*)((BUF) + aoff[t][ks]); bfr[t] = *(const bf16x8*)((BUF) + boff[t][ks]); } \
            __builtin_amdgcn_s_setprio(1); \
            _Pragma("unroll") for (int mt = 0; mt < 4; ++mt) _Pragma("unroll") for (int nt = 0; nt < 4; ++nt) acc[mt][nt] = mfma16(bfr[nt], af[mt], acc[mt][nt]); \
            __builtin_amdgcn_s_setprio(0); } } while (0)
        GLOAD(ra0, rb0, 0);
        GLOAD(ra1, rb1, 1);
        LSTORE(ra0, rb0, lds);
        __syncthreads();
        for (int kt = 0; kt < nk; kt += 2) {
            if (kt + 2 < nk) GLOAD(ra0, rb0, kt + 2);
            COMPUTE(lds);
            LSTORE(ra1, rb1, lds + 32768);
            __syncthreads();
            if (kt + 3 < nk) GLOAD(ra1, rb1, kt + 3);
            COMPUTE(lds + 32768);
            if (kt + 2 < nk) LSTORE(ra0, rb0, lds);
            __syncthreads();
        }
#undef GLOAD
#undef LSTORE
#undef COMPUTE
#pragma unroll
        for (int mt = 0; mt < 4; ++mt) {
            const int row = m0 + wm * 64 + mt * 16 + l15;
            const int b = row / TB, t = row - b * TB;
            if (EPI == 0) {
#pragma unroll
                for (int nt = 0; nt < 4; nt += 2) {
                    const int hc = ((n0 + wn * 64 + nt * 16) >> 1) + quad * 4;
                    const f32x4 g = acc[mt][nt], u = acc[mt][nt + 1];
                    u32x2 o; o.x = cvt_pk_bf16(siluf(g[0]) * u[0], siluf(g[1]) * u[1]); o.y = cvt_pk_bf16(siluf(g[2]) * u[2], siluf(g[3]) * u[3]);
                    *(u32x2*)(e.obf + (size_t)row * DFF + hc) = o;
                }
            } else if (EPI == 2) {
#pragma unroll
                for (int nt = 0; nt < 4; ++nt) {
                    const int col = n0 + wn * 64 + nt * 16 + quad * 4;
                    u32x2 o; o.x = cvt_pk_bf16(acc[mt][nt][0], acc[mt][nt][1]); o.y = cvt_pk_bf16(acc[mt][nt][2], acc[mt][nt][3]);
                    *(u32x2*)(e.obf + (size_t)row * e.ldo + col) = o;
                }
            } else {
                const int mr = (t < TC) ? 8 : b;
                const float* gp = e.gate + (size_t)mr * 9216;
#pragma unroll
                for (int nt = 0; nt < 4; ++nt) {
                    const int col = n0 + wn * 64 + nt * 16 + quad * 4;
                    const f32x4 gv = *(const f32x4*)(gp + col);
                    f32x4 h = *(const f32x4*)(e.H + (size_t)row * D + col);
                    h += (gv * e.gscale) * acc[mt][nt];
                    if (e.outp == nullptr) *(f32x4*)(e.H + (size_t)row * D + col) = h;
                    else if (t >= TC) *(f32x4*)(e.outp + ((size_t)b * TL + (t - TC)) * D + col) = h;
                }
            }
        }
    }
}

template <int EPI>
__device__ __forceinline__ void gemm256_phase(const bf16_t* A, const bf16_t* Bt, int K, int nN, bool skip_ctx, const EpiArgs e, char* lds) {
    const int tid = opaque_tid(), lane = tid & 63, w = tid >> 6, wm = w >> 1, wn = w & 1, l15 = lane & 15, quad = lane >> 4;
    const int nk = K >> 5;
    const int gsel_w = (tid >> 4) & 3, gw = (gsel_w == 0) ? 0 : (gsel_w == 1) ? 2 : (gsel_w == 2) ? 3 : 1;
    const int woff = (tid >> 2) * 64 + (((tid & 3) ^ gw) << 4);
    const int gsel_r = (l15 >> 2) & 3, gr = (gsel_r == 0) ? 0 : (gsel_r == 1) ? 2 : (gsel_r == 2) ? 3 : 1;
    const int aoff = (wm * 128 + l15) * 64 + ((quad ^ gr) << 4);
    const int boff = 16384 + (wn * 64 + l15) * 64 + ((quad ^ gr) << 4);
    const int ntm = skip_ctx ? 64 : 72;
    const int xcd = blockIdx.x & 7, lblk = blockIdx.x >> 3, nlb = gridDim.x >> 3, ntmx = ntm >> 3, ntx = ntmx * nN, nfull = (nN >> 3) << 3;
    for (int lt = lblk; lt < ntx; lt += nlb) {
        int tml, tn;
        if (lt < ntmx * nfull) { const int g = lt / (ntmx * 8), rem = lt - g * (ntmx * 8); tml = rem >> 3; tn = g * 8 + (rem & 7); }
        else { const int l2 = lt - ntmx * nfull, gwd = nN - nfull; tml = l2 / gwd; tn = nfull + (l2 - tml * gwd); }
        const int tmi = xcd * ntmx + tml;
        const int tm = skip_ctx ? (tmi >> 3) * 9 + 1 + (tmi & 7) : tmi;
        const int m0 = tm * 256, n0 = tn * 128;
        const bf16_t* ag = A + (size_t)(m0 + (tid >> 2)) * K + (tid & 3) * 8;
        const bf16_t* bg = Bt + (size_t)(n0 + (tid >> 2)) * K + (tid & 3) * 8;
        f32x4 acc[8][4];
#pragma unroll
        for (int i = 0; i < 8; ++i)
#pragma unroll
            for (int j = 0; j < 4; ++j) acc[i][j] = (f32x4){0.f, 0.f, 0.f, 0.f};
        u32x4 ra0[4], rb0[2], ra1[4], rb1[2];
#define G2LOAD(RA, RB, KT) do { _Pragma("unroll") for (int i = 0; i < 4; ++i) RA[i] = *(const u32x4*)(ag + (size_t)i * 64 * K + (KT) * 32); \
                        _Pragma("unroll") for (int i = 0; i < 2; ++i) RB[i] = *(const u32x4*)(bg + (size_t)i * 64 * K + (KT) * 32); } while (0)
#define L2STORE(RA, RB, BUF) do { _Pragma("unroll") for (int i = 0; i < 4; ++i) *(u32x4*)((BUF) + woff + i * 4096) = RA[i]; \
                          _Pragma("unroll") for (int i = 0; i < 2; ++i) *(u32x4*)((BUF) + 16384 + woff + i * 4096) = RB[i]; } while (0)
#define C2MPUTE(BUF) do { bf16x8 bfr[4], af[4]; \
            _Pragma("unroll") for (int t = 0; t < 4; ++t) { bfr[t] = *(const bf16x8*)((BUF) + boff + t * 1024); af[t] = *(const bf16x8*)((BUF) + aoff + t * 1024); } \
            __builtin_amdgcn_s_setprio(1); \
            _Pragma("unroll") for (int mt = 0; mt < 4; ++mt) _Pragma("unroll") for (int nt = 0; nt < 4; ++nt) acc[mt][nt] = mfma16(bfr[nt], af[mt], acc[mt][nt]); \
            __builtin_amdgcn_s_setprio(0); \
            _Pragma("unroll") for (int t = 0; t < 4; ++t) af[t] = *(const bf16x8*)((BUF) + aoff + (4 + t) * 1024); \
            __builtin_amdgcn_s_setprio(1); \
            _Pragma("unroll") for (int mt = 0; mt < 4; ++mt) _Pragma("unroll") for (int nt = 0; nt < 4; ++nt) acc[4 + mt][nt] = mfma16(bfr[nt], af[mt], acc[4 + mt][nt]); \
            __builtin_amdgcn_s_setprio(0); } while (0)
        G2LOAD(ra0, rb0, 0);
        G2LOAD(ra1, rb1, 1);
        L2STORE(ra0, rb0, lds);
        __syncthreads();
        for (int kt = 0; kt < nk; kt += 2) {
            if (kt + 2 < nk) G2LOAD(ra0, rb0, kt + 2);
            C2MPUTE(lds);
            L2STORE(ra1, rb1, lds + 24576);
            __syncthreads();
            if (kt + 3 < nk) G2LOAD(ra1, rb1, kt + 3);
            C2MPUTE(lds + 24576);
            if (kt + 2 < nk) L2STORE(ra0, rb0, lds);
            __syncthreads();
        }
#undef G2LOAD
#undef L2STORE
#undef C2MPUTE
#pragma unroll
        for (int mt = 0; mt < 8; ++mt) {
            const int row = m0 + wm * 128 + mt * 16 + l15;
            if (EPI == 0) {
#pragma unroll
                for (int nt = 0; nt < 4; nt += 2) {
                    const int hc = ((n0 + wn * 64 + nt * 16) >> 1) + quad * 4;
                    const f32x4 g = acc[mt][nt], u = acc[mt][nt + 1];
                    u32x2 o; o.x = cvt_pk_bf16(siluf(g[0]) * u[0], siluf(g[1]) * u[1]); o.y = cvt_pk_bf16(siluf(g[2]) * u[2], siluf(g[3]) * u[3]);
                    *(u32x2*)(e.obf + (size_t)row * DFF + hc) = o;
                }
            } else {
#pragma unroll
                for (int nt = 0; nt < 4; ++nt) {
                    const int col = n0 + wn * 64 + nt * 16 + quad * 4;
                    u32x2 o; o.x = cvt_pk_bf16(acc[mt][nt][0], acc[mt][nt][1]); o.y = cvt_pk_bf16(acc[mt][nt][2], acc[mt][nt][3]);
                    *(u32x2*)(e.obf + (size_t)row * e.ldo + col) = o;
                }
            }
        }
    }
}

__device__ __forceinline__ int kpos(int x) { return (x & 32) + (((x & 15) >> 2) * 8 + ((x >> 4) & 1) * 4 + (x & 3)); }
__device__ __forceinline__ size_t vt_off(int dv, int t) { const int w = t & 31; return ((size_t)(t >> 5) * 64 + dv) * 32 + (((w & 15) >> 2) * 8 + ((w >> 4) & 1) * 4 + (w & 3)); }
__device__ __forceinline__ void ld8f(const bf16_t* p, float (&x)[8]) {
    const u32x4 v = *(const u32x4*)p;
    x[0] = bflo(v.x); x[1] = bfhi(v.x); x[2] = bflo(v.y); x[3] = bfhi(v.y); x[4] = bflo(v.z); x[5] = bfhi(v.z); x[6] = bflo(v.w); x[7] = bfhi(v.w);
}
__device__ __forceinline__ void st8f(bf16_t* p, const float (&y)[8]) {
    u32x4 o; o.x = cvt_pk_bf16(y[0], y[1]); o.y = cvt_pk_bf16(y[2], y[3]); o.z = cvt_pk_bf16(y[4], y[5]); o.w = cvt_pk_bf16(y[6], y[7]);
    *(u32x4*)p = o;
}
__device__ __forceinline__ void prep_phase(const Params& p, int layer, char* lds) {
    const bf16_t* P = (const bf16_t*)(p.ws + OFF_BIG);
    char* dob = (char*)p.out;
    bf16_t *QA = (bf16_t*)(dob + DO_QA), *KA = (bf16_t*)(dob + DO_KA), *VAT = (bf16_t*)(dob + DO_VAT), *QB = (bf16_t*)(dob + DO_QB), *KB = (bf16_t*)(dob + DO_KB), *VBT = (bf16_t*)(dob + DO_VBT);
    bf16_t *QC = (bf16_t*)(p.ws + OFF_QC), *KC = (bf16_t*)(p.ws + OFF_KC), *VC = (bf16_t*)(p.ws + OFF_VC);
    bf16_t* Y = (bf16_t*)(p.ws + OFF_HN);
    float *G = (float*)(p.ws + OFF_G), *BETA = (float*)(p.ws + OFF_BETA);
    const float *aq = p.a_qnorm + layer * 32, *ak = p.a_knorm + layer * 32, *bq = p.b_qnorm + layer * 64, *bk = p.b_knorm + layer * 64;
    const float *cw = p.c_conv + (size_t)layer * 5 * 1152, *alog = p.c_A_log + layer * 12, *dtb = p.c_dt_bias + layer * 12;
    const int tid = opaque_tid(), lane = tid & 63, w = tid >> 6;
    unsigned* TT = (unsigned*)lds;
    float* CW = (float*)(lds + 12544);
    float* RA = (float*)(lds + 12544 + 23040);
    float* RB = RA + 1024;
    for (int i = tid; i < 5 * 1152; i += 256) CW[i] = cw[i];
    for (int i = tid; i < 512; i += 256) { const int pos = i >> 3, f = i & 7; float sn, cs; sincosf((float)pos * exp2f(-(float)f * (13.287712379549449f / 8.f)), &sn, &cs); RA[i * 2] = cs; RA[i * 2 + 1] = sn; }
    for (int i = tid; i < 1024; i += 256) { const int pos = i >> 4, f = i & 15; float sn, cs; sincosf((float)pos * exp2f(-(float)f * (13.287712379549449f / 16.f)), &sn, &cs); RB[i * 2] = cs; RB[i * 2 + 1] = sn; }
    __syncthreads();
    for (int tile = blockIdx.x; tile < M / 16; tile += gridDim.x) {
        const int row0 = tile * 16, b = row0 / TB, t0 = row0 - b * TB;
        const bool is_ctx = t0 < TC;
        for (int idx = tid; idx < 16 * 192; idx += 256) {
            const int tok = idx / 192, cp = idx - tok * 192, c2 = cp * 2;
            const int col = (c2 < 256) ? 512 + c2 : 1280 + (c2 - 256);
            TT[tok * 193 + cp] = *(const unsigned*)(P + (size_t)(row0 + tok) * NINP + col);
        }
#pragma unroll 2
        for (int task = w; task < 32; task += 4) {
            const int tok = task >> 1, isB = task & 1, row = row0 + tok, t = t0 + tok, tl = t - TC;
            const int prow_pos = tl >> 6, pcol_pos = tl & 63;
            const bf16_t* prow = P + (size_t)row * NINP;
            float x[8], y[8];
            if (!isB) {
                const int c = lane;
                const bool isq = c < 32; const int hh = (c >> 3) & 3, mp = (c >> 2) & 1, cc = c & 3;
                ld8f(prow + c * 8, x);
                float ss = 0.f;
#pragma unroll
                for (int j = 0; j < 8; ++j) ss += x[j] * x[j];
                ss += __shfl_xor(ss, 1); ss += __shfl_xor(ss, 2);
                const float r = rsqrtf(ss * (1.f / 32.f) + EPS);
                const float* wn = (isq ? aq : ak) + cc * 8;
#pragma unroll
                for (int j = 0; j < 8; ++j) y[j] = x[j] * r * wn[j];
                if (!is_ctx) {
                    const float* tb = RA + ((cc < 2 ? prow_pos : pcol_pos) * 8) * 2;
#pragma unroll
                    for (int j = 0; j < 8; ++j) {
                        const float pr = __shfl_xor(y[j], 1), cs = tb[j * 2], sn = tb[j * 2 + 1];
                        y[j] = y[j] * cs + pr * ((cc & 1) ? sn : -sn);
                    }
                }
                st8f((isq ? QA : KA) + ((size_t)((b * 4 + hh) * 2 + mp) * TB + t) * 32 + cc * 8, y);
            } else {
                const int c = lane;
                const bool isq = c < 48; const int hh = isq ? (c >> 3) : ((c - 48) >> 3), cc = c & 7;
                ld8f(prow + 768 + c * 8, x);
                float ss = 0.f;
#pragma unroll
                for (int j = 0; j < 8; ++j) ss += x[j] * x[j];
                ss += __shfl_xor(ss, 1); ss += __shfl_xor(ss, 2); ss += __shfl_xor(ss, 4);
                const float r = rsqrtf(ss * (1.f / 64.f) + EPS);
                const float* wn = (isq ? bq : bk) + cc * 8;
#pragma unroll
                for (int j = 0; j < 8; ++j) y[j] = x[j] * r * wn[j];
                if (!is_ctx) {
                    const float* tb = RB + ((cc < 4 ? prow_pos : pcol_pos) * 16 + (cc & 1) * 8) * 2;
#pragma unroll
                    for (int j = 0; j < 8; ++j) {
                        const float pr = __shfl_xor(y[j], 2), cs = tb[j * 2], sn = tb[j * 2 + 1];
                        y[j] = y[j] * cs + pr * ((cc & 2) ? sn : -sn);
                    }
                }
                st8f((isq ? QB + ((size_t)(b * 6 + hh) * TB + t) * 64 : KB + ((size_t)(b * 2 + hh) * TB + t) * 64) + cc * 8, y);
            }
        }
#pragma unroll 2
        for (int task = w; task < 48; task += 4) {
            const int tok = task / 3, cidx = (task - tok * 3) * 64 + lane, row = row0 + tok, t = t0 + tok;
            if (cidx < 144) {
                const int part = cidx / 48, hh = (cidx - part * 48) >> 3, cc = cidx & 7;
                const int ts = is_ctx ? 0 : TC, len = is_ctx ? TC : TL, tq = t - ts;
                float a[8];
#pragma unroll
                for (int j = 0; j < 8; ++j) a[j] = 0.f;
#pragma unroll
                for (int i = 0; i < 5; ++i) {
                    const int tt = tq + i - 2;
                    if (tt >= 0 && tt < len) {
                        float x[8]; ld8f(P + (size_t)(row + i - 2) * NINP + 1408 + cidx * 8, x);
                        const f32x4 w0 = *(const f32x4*)(CW + i * 1152 + cidx * 8), w1 = *(const f32x4*)(CW + i * 1152 + cidx * 8 + 4);
                        a[0] += w0[0] * x[0]; a[1] += w0[1] * x[1]; a[2] += w0[2] * x[2]; a[3] += w0[3] * x[3];
                        a[4] += w1[0] * x[4]; a[5] += w1[1] * x[5]; a[6] += w1[2] * x[6]; a[7] += w1[3] * x[7];
                    }
                }
                float ss = 0.f;
#pragma unroll
                for (int j = 0; j < 8; ++j) { a[j] = siluf(a[j]); ss += a[j] * a[j]; }
                ss += __shfl_xor(ss, 1); ss += __shfl_xor(ss, 2); ss += __shfl_xor(ss, 4);
                if (part < 2) {
                    const float r = rsqrtf(ss + EPS) * (part == 0 ? 0.125f : 1.f);
#pragma unroll
                    for (int j = 0; j < 8; ++j) a[j] *= r;
                }
                if (part == 2) st8f(VC + (size_t)row * 384 + hh * 64 + cc * 8, a);
                else {
                    bf16_t* dst = (part == 0 ? QC : KC) + (size_t)row * 384 + hh * 64;
                    u32x2 o0, o1; o0.x = cvt_pk_bf16(a[0], a[1]); o0.y = cvt_pk_bf16(a[2], a[3]); o1.x = cvt_pk_bf16(a[4], a[5]); o1.y = cvt_pk_bf16(a[6], a[7]);
                    *(u32x2*)(dst + kpos(cc * 8)) = o0; *(u32x2*)(dst + kpos(cc * 8 + 4)) = o1;
                }
            }
        }
        for (int idx = tid; idx < 16 * 24; idx += 256) {
            const int tok = idx / 24, j = idx - tok * 24, row = row0 + tok;
            if (j < 12) {
                const float a = bf2f(P[(size_t)row * NINP + 2944 + j]) + dtb[j];
                const float sp = fmaxf(a, 0.f) + log1pf(__expf(-fabsf(a)));
                G[(size_t)row * 12 + j] = -__expf(alog[j]) * sp;
            } else {
                const float bb = bf2f(P[(size_t)row * NINP + 2956 + (j - 12)]);
                BETA[(size_t)row * 12 + (j - 12)] = 1.f / (1.f + __expf(-bb));
            }
        }
        for (int idx = tid; idx < 16 * 48; idx += 256) {
            const int tok = idx / 48, cp = idx - tok * 48;
            float x[8]; ld8f(P + (size_t)(row0 + tok) * NINP + 2560 + cp * 8, x);
#pragma unroll
            for (int j = 0; j < 8; ++j) x[j] = siluf(x[j]);
            st8f(Y + (size_t)(row0 + tok) * D + 640 + cp * 8, x);
        }
        __syncthreads();
        {
            const int tok = tid & 15;
            for (int cidx = tid >> 4; cidx < 384; cidx += 16) {
                const unsigned v2 = TT[tok * 193 + (cidx >> 1)];
                const bf16_t v = (cidx & 1) ? (bf16_t)(v2 >> 16) : (bf16_t)(v2 & 0xffff);
                if (cidx < 256) VAT[(size_t)(b * 4 + (cidx >> 6)) * 64 * TB + vt_off(cidx & 63, t0 + tok)] = v;
                else { const int c2 = cidx - 256; VBT[(size_t)(b * 2 + (c2 >> 6)) * 64 * TB + vt_off(c2 & 63, t0 + tok)] = v; }
            }
        }
        __syncthreads();
    }
}

template <int DQK>
__device__ __forceinline__ void attn_wave(const bf16_t* Q, const bf16_t* Kp, const bf16_t* VT, int qt0, int kbeg, int kend, int k2beg, int k2end,
                                          float c1, float c2, f32x4 (&acc)[2][4], float (&lsum)[2], int lane) {
    constexpr int KS = DQK / 32;
    const int l15 = lane & 15, quad = lane >> 4;
    bf16x8 qf[2][KS];
#pragma unroll
    for (int qt = 0; qt < 2; ++qt)
#pragma unroll
        for (int ks = 0; ks < KS; ++ks) qf[qt][ks] = ld8(Q + (size_t)(qt0 + qt * 16 + l15) * DQK + ks * 32 + quad * 8);
    const bf16_t* kbase = Kp + (size_t)l15 * DQK + quad * 8;
    const bf16_t* vbase = VT + (size_t)l15 * 32 + quad * 8;
#pragma unroll 1
    for (int rg = 0; rg < 2; ++rg) {
        const int kb0 = rg ? k2beg : kbeg, kb1 = rg ? k2end : kend;
        const bool band = rg != 0;
        if (kb0 >= kb1) continue;
        bf16x8 kf[2][KS], vf[4];
#pragma unroll
        for (int kt = 0; kt < 2; ++kt)
#pragma unroll
            for (int ks = 0; ks < KS; ++ks) kf[kt][ks] = ld8(kbase + (size_t)(kb0 + kt * 16) * DQK + ks * 32);
#pragma unroll
        for (int dt = 0; dt < 4; ++dt) vf[dt] = ld8(vbase + (size_t)(kb0 >> 5) * 2048 + dt * 512);
#pragma unroll 1
        for (int kb = kb0; kb < kb1; kb += 32) {
            const int kn = (kb + 32 < kb1) ? kb + 32 : kb;
            bf16x8 kfn[2][KS], vfn[4];
#pragma unroll
            for (int kt = 0; kt < 2; ++kt)
#pragma unroll
                for (int ks = 0; ks < KS; ++ks) kfn[kt][ks] = ld8(kbase + (size_t)(kn + kt * 16) * DQK + ks * 32);
#pragma unroll
            for (int dt = 0; dt < 4; ++dt) vfn[dt] = ld8(vbase + (size_t)(kn >> 5) * 2048 + dt * 512);
#pragma unroll
            for (int qt = 0; qt < 2; ++qt) {
                f32x4 s[2];
#pragma unroll
                for (int kt = 0; kt < 2; ++kt) {
                    s[kt] = (f32x4){0.f, 0.f, 0.f, 0.f};
#pragma unroll
                    for (int ks = 0; ks < KS; ++ks) s[kt] = mfma16(kf[kt][ks], qf[qt][ks], s[kt]);
                }
                float ps = 0.f;
#pragma unroll
                for (int kt = 0; kt < 2; ++kt)
#pragma unroll
                    for (int j = 0; j < 4; ++j) {
                        float pv = __builtin_amdgcn_exp2f(s[kt][j] * c1 - c2);
                        if (band) {
                            const int dd = (qt0 + qt * 16 + l15) - (kb + kt * 16 + quad * 4 + j);
                            if (dd > 128 || dd < -128) pv = 0.f;
                        }
                        s[kt][j] = pv; ps += pv;
                    }
                lsum[qt] += ps;
                const bf16x8 pf = pack8(s[0], s[1]);
#pragma unroll
                for (int dt = 0; dt < 4; ++dt) acc[qt][dt] = mfma16(vf[dt], pf, acc[qt][dt]);
            }
#pragma unroll
            for (int kt = 0; kt < 2; ++kt)
#pragma unroll
                for (int ks = 0; ks < KS; ++ks) kf[kt][ks] = kfn[kt][ks];
#pragma unroll
            for (int dt = 0; dt < 4; ++dt) vf[dt] = vfn[dt];
        }
    }
}

__device__ __forceinline__ void attnA_item(const Params& p, int layer, int b, int h, int qt_first  , int kend, float lam_init, char* lds) {
    char* dob = (char*)p.out;
    const bf16_t *QA = (const bf16_t*)(dob + DO_QA), *KA = (const bf16_t*)(dob + DO_KA), *VAT = (const bf16_t*)(dob + DO_VAT);
    bf16_t* Y = (bf16_t*)(p.ws + OFF_HN);
    const int tida = opaque_tid();
    const int lane = tida & 63, w = tida >> 6, l15 = lane & 15, quad = lane >> 4;
    const float* lf = p.a_lambda + layer * 128;
    float sa = 0.f, sb = 0.f;
    if (lane < 32) { sa = lf[lane] * lf[32 + lane]; sb = lf[64 + lane] * lf[96 + lane]; }
    sa = wave_sum(sa); sb = wave_sum(sb);
    const float lam = __expf(sa) - __expf(sb) + lam_init;
    const float mq = wave_max(fabsf(p.a_qnorm[layer * 32 + (lane & 31)])), mk = wave_max(fabsf(p.a_knorm[layer * 32 + (lane & 31)]));
    const float scale = 0.17677669529663687f;
    const float c1 = scale * LOG2E, c2 = 32.f * mq * mk * scale * LOG2E;
    const int qt0 = qt_first + w * 32;
    const size_t ho = (size_t)((b * 4 + h) * 2) * TB * 32, mo = (size_t)TB * 32;
    f32x4 acc[2][2][4]; float ls[2][2];
    bf16x8 qf[2][2];
#pragma unroll
    for (int m = 0; m < 2; ++m)
#pragma unroll
        for (int qt = 0; qt < 2; ++qt) {
            ls[m][qt] = 0.f;
            qf[m][qt] = ld8(QA + ho + m * mo + (size_t)(qt0 + qt * 16 + l15) * 32 + quad * 8);
#pragma unroll
            for (int dt = 0; dt < 4; ++dt) acc[m][qt][dt] = (f32x4){0.f, 0.f, 0.f, 0.f};
        }
    const int gsw = (tida >> 4) & 3, gws = (gsw == 0) ? 0 : (gsw == 1) ? 2 : (gsw == 2) ? 3 : 1;
    const int srow = (tida >> 2) & 63, sch = tida & 3;
    const bf16_t* kg = KA + ho + (size_t)(tida >> 7) * mo + (size_t)((tida >> 2) & 31) * 32 + sch * 8;
    const bf16_t* vg = VAT + (size_t)(b * 4 + h) * 64 * TB + (size_t)srow * 32 + sch * 8;
    const int kw = (tida >> 7) * 2048 + ((tida >> 2) & 31) * 64 + ((sch ^ gws) << 4);
    const int vw = 4096 + srow * 64 + ((sch ^ gws) << 4);
    const int gsr = (l15 >> 2) & 3, grs = (gsr == 0) ? 0 : (gsr == 1) ? 2 : (gsr == 2) ? 3 : 1;
    const int fo = l15 * 64 + ((quad ^ grs) << 4);
    u32x4 rk = *(const u32x4*)kg, rv = *(const u32x4*)vg;
    *(u32x4*)(lds + kw) = rk; *(u32x4*)(lds + vw) = rv;
    __syncthreads();
#pragma unroll 1
    for (int kb = 0; kb < kend; kb += 32) {
        char* cur = lds + ((kb >> 5) & 1) * 8192;
        char* nxt = lds + (((kb >> 5) + 1) & 1) * 8192;
        const bool more = kb + 32 < kend;
        if (more) { rk = *(const u32x4*)(kg + (size_t)(kb + 32) * 32); rv = *(const u32x4*)(vg + (size_t)((kb + 32) >> 5) * 2048); }
        bf16x8 kf[2][2], vf[4];
#pragma unroll
        for (int m = 0; m < 2; ++m)
#pragma unroll
            for (int kt = 0; kt < 2; ++kt) kf[m][kt] = *(const bf16x8*)(cur + m * 2048 + kt * 1024 + fo);
#pragma unroll
        for (int dt = 0; dt < 4; ++dt) vf[dt] = *(const bf16x8*)(cur + 4096 + dt * 1024 + fo);
#pragma unroll
        for (int m = 0; m < 2; ++m)
#pragma unroll
            for (int qt = 0; qt < 2; ++qt) {
                f32x4 s[2];
#pragma unroll
                for (int kt = 0; kt < 2; ++kt) s[kt] = mfma16(kf[m][kt], qf[m][qt], (f32x4){0.f, 0.f, 0.f, 0.f});
                float ps = 0.f;
#pragma unroll
                for (int kt = 0; kt < 2; ++kt)
#pragma unroll
                    for (int j = 0; j < 4; ++j) { const float pv = __builtin_amdgcn_exp2f(s[kt][j] * c1 - c2); s[kt][j] = pv; ps += pv; }
                ls[m][qt] += ps;
                const bf16x8 pf = pack8(s[0], s[1]);
#pragma unroll
                for (int dt = 0; dt < 4; ++dt) acc[m][qt][dt] = mfma16(vf[dt], pf, acc[m][qt][dt]);
            }
        if (more) { *(u32x4*)(nxt + kw) = rk; *(u32x4*)(nxt + vw) = rv; }
        __syncthreads();
    }
    const float* sub = p.a_subln + layer * 64;
#pragma unroll
    for (int qt = 0; qt < 2; ++qt) {
        float l0 = ls[0][qt], l1 = ls[1][qt];
        l0 += __shfl_xor(l0, 16); l0 += __shfl_xor(l0, 32); l1 += __shfl_xor(l1, 16); l1 += __shfl_xor(l1, 32);
        const float i0 = 1.f / l0, i1 = lam / l1;
        f32x4 o[4]; float ss = 0.f;
#pragma unroll
        for (int dt = 0; dt < 4; ++dt) { o[dt] = acc[0][qt][dt] * i0 - acc[1][qt][dt] * i1; ss += o[dt][0] * o[dt][0] + o[dt][1] * o[dt][1] + o[dt][2] * o[dt][2] + o[dt][3] * o[dt][3]; }
        ss += __shfl_xor(ss, 16); ss += __shfl_xor(ss, 32);
        const float r = rsqrtf(ss * (1.f / 64.f) + EPS) * (1.f - lam_init);
        const size_t row = (size_t)b * TB + qt0 + qt * 16 + l15;
#pragma unroll
        for (int dt = 0; dt < 4; ++dt) {
            const int dv = dt * 16 + quad * 4;
            const f32x4 sw = *(const f32x4*)(sub + dv);
            u32x2 ov; ov.x = cvt_pk_bf16(o[dt][0] * r * sw[0], o[dt][1] * r * sw[1]); ov.y = cvt_pk_bf16(o[dt][2] * r * sw[2], o[dt][3] * r * sw[3]);
            *(u32x2*)(Y + row * D + h * 64 + dv) = ov;
        }
    }
}

__device__ __forceinline__ void attnB_item(const Params& p, int layer, int b, int hq, int qt_first, bool lat, char* lds) {
    char* dob = (char*)p.out;
    const bf16_t *QB = (const bf16_t*)(dob + DO_QB), *KB = (const bf16_t*)(dob + DO_KB), *VBT = (const bf16_t*)(dob + DO_VBT);
    bf16_t* Y = (bf16_t*)(p.ws + OFF_HN);
    const int tidb = opaque_tid();
    const int lane = tidb & 63, w = tidb >> 6, l15 = lane & 15, quad = lane >> 4, kvh = hq / 3;
    const float mq = wave_max(fabsf(p.b_qnorm[layer * 64 + lane])), mk = wave_max(fabsf(p.b_knorm[layer * 64 + lane]));
    const float scale = 0.125f, c1 = scale * LOG2E, c2 = 64.f * mq * mk * scale * LOG2E;
    const int qt0 = qt_first + w * 32;
    f32x4 acc[2][4]; float ls[2] = {0.f, 0.f};
#pragma unroll
    for (int qt = 0; qt < 2; ++qt)
#pragma unroll
        for (int dt = 0; dt < 4; ++dt) acc[qt][dt] = (f32x4){0.f, 0.f, 0.f, 0.f};
    const bf16_t* Qp = QB + (size_t)(b * 6 + hq) * TB * 64;
    const bf16_t* Kp = KB + (size_t)(b * 2 + kvh) * TB * 64;
    const bf16_t* Vp = VBT + (size_t)(b * 2 + kvh) * 64 * TB;
    int lo = 0, nst = 8;
    if (lat) {
        lo = qt_first - 128; if (lo < TC) lo = TC;
        int hi = qt_first + 128 + 128; if (hi > TB) hi = TB;
        lo &= ~31; hi = (hi + 31) & ~31;
        nst += (hi - lo) >> 5;
    }
    bf16x8 qf[2][2];
#pragma unroll
    for (int qt = 0; qt < 2; ++qt)
#pragma unroll
        for (int ks = 0; ks < 2; ++ks) qf[qt][ks] = ld8(Qp + (size_t)(qt0 + qt * 16 + l15) * 64 + ks * 32 + quad * 8);
    const int skey = tidb >> 3, skc = tidb & 7;
    const int sdv = tidb >> 2, svc = tidb & 3;
    const int gsw = (tidb >> 4) & 3, gws = (gsw == 0) ? 0 : (gsw == 1) ? 2 : (gsw == 2) ? 3 : 1;
    const bf16_t* kg = Kp + (size_t)skey * 64 + skc * 8;
    const bf16_t* vg = Vp + (size_t)sdv * 32 + svc * 8;
    const int kw = skey * 128 + ((skc ^ ((skey >> 1) & 7)) << 4);
    const int vw = 4096 + sdv * 64 + ((svc ^ gws) << 4);
    const int gsr = (l15 >> 2) & 3, grs = (gsr == 0) ? 0 : (gsr == 1) ? 2 : (gsr == 2) ? 3 : 1;
    const int kfo = l15 * 128;
    const int vfo = 4096 + l15 * 64 + ((quad ^ grs) << 4);
    u32x4 rk = *(const u32x4*)kg, rv = *(const u32x4*)vg;
    *(u32x4*)(lds + kw) = rk; *(u32x4*)(lds + vw) = rv;
    __syncthreads();
#pragma unroll 1
    for (int st = 0; st < nst; ++st) {
        const int kb = (st < 8) ? st * 32 : lo + (st - 8) * 32;
        const bool band = st >= 8;
        char* cur = lds + (st & 1) * 8192;
        char* nxt = lds + ((st + 1) & 1) * 8192;
        const bool more = st + 1 < nst;
        if (more) { const int kn = (st + 1 < 8) ? (st + 1) * 32 : lo + (st + 1 - 8) * 32; rk = *(const u32x4*)(kg + (size_t)kn * 64); rv = *(const u32x4*)(vg + (size_t)(kn >> 5) * 2048); }
        bf16x8 kf[2][2], vf[4];
#pragma unroll
        for (int kt = 0; kt < 2; ++kt)
#pragma unroll
            for (int ks = 0; ks < 2; ++ks) kf[kt][ks] = *(const bf16x8*)(cur + kt * 2048 + kfo + (((ks * 4 + quad) ^ (l15 >> 1)) << 4));
#pragma unroll
        for (int dt = 0; dt < 4; ++dt) vf[dt] = *(const bf16x8*)(cur + vfo + dt * 1024);
#pragma unroll
        for (int qt = 0; qt < 2; ++qt) {
            f32x4 s[2];
#pragma unroll
            for (int kt = 0; kt < 2; ++kt) {
                s[kt] = (f32x4){0.f, 0.f, 0.f, 0.f};
#pragma unroll
                for (int ks = 0; ks < 2; ++ks) s[kt] = mfma16(kf[kt][ks], qf[qt][ks], s[kt]);
            }
            float ps = 0.f;
#pragma unroll
            for (int kt = 0; kt < 2; ++kt)
#pragma unroll
                for (int j = 0; j < 4; ++j) {
                    float pv = __builtin_amdgcn_exp2f(s[kt][j] * c1 - c2);
                    if (band) {
                        const int dd = (qt0 + qt * 16 + l15) - (kb + kt * 16 + quad * 4 + j);
                        if (dd > 128 || dd < -128) pv = 0.f;
                    }
                    s[kt][j] = pv; ps += pv;
                }
            ls[qt] += ps;
            const bf16x8 pf = pack8(s[0], s[1]);
#pragma unroll
            for (int dt = 0; dt < 4; ++dt) acc[qt][dt] = mfma16(vf[dt], pf, acc[qt][dt]);
        }
        if (more) { *(u32x4*)(nxt + kw) = rk; *(u32x4*)(nxt + vw) = rv; }
        __syncthreads();
    }
    const float snk = exp2f(p.b_sink[layer * 6 + hq] * LOG2E - c2);
#pragma unroll
    for (int qt = 0; qt < 2; ++qt) {
        float l0 = ls[qt]; l0 += __shfl_xor(l0, 16); l0 += __shfl_xor(l0, 32);
        const float inv = 1.f / (l0 + snk);
        const size_t row = (size_t)b * TB + qt0 + qt * 16 + l15;
#pragma unroll
        for (int dt = 0; dt < 4; ++dt) {
            const int dv = dt * 16 + quad * 4;
            u32x2 ov; ov.x = cvt_pk_bf16(acc[qt][dt][0] * inv, acc[qt][dt][1] * inv); ov.y = cvt_pk_bf16(acc[qt][dt][2] * inv, acc[qt][dt][3] * inv);
            *(u32x2*)(Y + row * D + 256 + hq * 64 + dv) = ov;
        }
    }
}

__device__ __forceinline__ void chunk_prep(const Params& p, int b, int c, int h, char* lds) {
    float* As = (float*)lds;
    float* Gs = As + 2 * 64 * 68;
    float* Bs = Gs + 128;
    bf16_t* KS = (bf16_t*)(lds + 35840);
    bf16_t* VS = KS + 4096;
    const bf16_t *QC = (const bf16_t*)(p.ws + OFF_QC), *KC = (const bf16_t*)(p.ws + OFF_KC), *VC = (const bf16_t*)(p.ws + OFF_VC);
    const float *G = (const float*)(p.ws + OFF_G), *BETA = (const float*)(p.ws + OFF_BETA);
    bf16_t* REC = (bf16_t*)(p.ws + OFF_BIG);
    float *EG = (float*)(p.ws + OFF_EG), *GL = (float*)(p.ws + OFF_GL);
    const int tid = opaque_tid(), lane = tid & 63, w = tid >> 6, l15 = lane & 15, quad = lane >> 4;
    const size_t row0 = (size_t)b * TB + c * 64;
    const size_t rec0 = ((size_t)(b * 36 + c) * 6 + h) * 2;
    {
        const int r = tid >> 3, ch = tid & 7;
        const u32x4 k0 = *(const u32x4*)(KC + (row0 + r) * 384 + h * 64 + ch * 8), k1 = *(const u32x4*)(KC + (row0 + r + 32) * 384 + h * 64 + ch * 8);
        const u32x4 v0 = *(const u32x4*)(VC + (row0 + r) * 384 + h * 64 + ch * 8), v1 = *(const u32x4*)(VC + (row0 + r + 32) * 384 + h * 64 + ch * 8);
        *(u32x4*)(KS + r * 64 + ch * 8) = k0; *(u32x4*)(KS + (r + 32) * 64 + ch * 8) = k1;
        *(u32x4*)(VS + r * 64 + ch * 8) = v0; *(u32x4*)(VS + (r + 32) * 64 + ch * 8) = v1;
    }
    if (w < 2) {
        const int d = w, tok = d ? 63 - lane : lane;
        float g = G[(row0 + tok) * 12 + d * 6 + h];
#pragma unroll
        for (int off = 1; off < 64; off <<= 1) { const float n = __shfl_up(g, off); if (lane >= off) g += n; }
        Gs[d * 64 + lane] = g; Bs[d * 64 + lane] = BETA[(row0 + tok) * 12 + d * 6 + h];
    }
    f32x4 kk[4], qk[4];
    {
        bf16x8 kj[4][2], ki[2], qi[2];
#pragma unroll
        for (int jt = 0; jt < 4; ++jt)
#pragma unroll
            for (int ks = 0; ks < 2; ++ks) kj[jt][ks] = ld8(KC + (row0 + jt * 16 + l15) * 384 + h * 64 + ks * 32 + quad * 8);
#pragma unroll
        for (int ks = 0; ks < 2; ++ks) { ki[ks] = ld8(KC + (row0 + w * 16 + l15) * 384 + h * 64 + ks * 32 + quad * 8); qi[ks] = ld8(QC + (row0 + w * 16 + l15) * 384 + h * 64 + ks * 32 + quad * 8); }
#pragma unroll
        for (int jt = 0; jt < 4; ++jt) {
            kk[jt] = (f32x4){0.f, 0.f, 0.f, 0.f}; qk[jt] = (f32x4){0.f, 0.f, 0.f, 0.f};
#pragma unroll
            for (int ks = 0; ks < 2; ++ks) { kk[jt] = mfma16(ki[ks], kj[jt][ks], kk[jt]); qk[jt] = mfma16(qi[ks], kj[jt][ks], qk[jt]); }
        }
    }
    __syncthreads();
    {
        bf16_t* R0 = REC + rec0 * 16384 + 8192;
        bf16_t* R1 = REC + (rec0 + 1) * 16384 + 8192;
#pragma unroll
        for (int jt = 0; jt < 4; ++jt)
#pragma unroll
            for (int r = 0; r < 4; ++r) {
                const int i = w * 16 + quad * 4 + r, j = jt * 16 + l15;
                const float kv = kk[jt][r], qv = qk[jt][r];
                {
                    const float dec = (i >= j) ? __expf(Gs[i] - Gs[j]) : 0.f;
                    if (i > j) As[i * 68 + j] = Bs[i] * kv * dec;
                    R0[i * 64 + kpos(j)] = f2bf(qv * dec);
                }
                {
                    const int ip = 63 - i, jp = 63 - j;
                    const float dec = (ip >= jp) ? __expf(Gs[64 + ip] - Gs[64 + jp]) : 0.f;
                    if (ip > jp) As[64 * 68 + ip * 68 + jp] = Bs[64 + ip] * kv * dec;
                    R1[ip * 64 + kpos(jp)] = f2bf(qv * dec);
                }
            }
    }
    __syncthreads();
    {
        const int d = tid >> 7, cc = tid & 127;
        const float* Ad = As + d * 64 * 68;
        const float* Gd = Gs + d * 64;
        const float* Bd = Bs + d * 64;
        float x[64];
        const bool isw = cc >= 64;
        const bf16_t* srcp = isw ? KS + kpos(cc - 64) : VS + cc;
#pragma unroll
        for (int g = 0; g < 4; ++g) {
#pragma unroll
            for (int q = 0; q < 16; ++q) {
                const int ip = g * 16 + q, tok = d ? 63 - ip : ip;
                x[ip] = Bd[ip] * (isw ? __expf(Gd[ip]) : 1.f) * bf2f(srcp[tok * 64]);
            }
            asm volatile("" ::: "memory");
        }
#pragma unroll
        for (int ip = 1; ip < 64; ++ip) {
            float s4[4] = {x[ip], 0.f, 0.f, 0.f};
#pragma unroll
            for (int j4 = 0; j4 < (ip + 3) / 4; ++j4) {
                const f32x4 a = *(const f32x4*)(Ad + ip * 68 + j4 * 4);
#pragma unroll
                for (int q = 0; q < 4; ++q) if (j4 * 4 + q < ip) s4[q] -= a[q] * x[j4 * 4 + q];
            }
            x[ip] = (s4[0] + s4[1]) + (s4[2] + s4[3]);
            if ((ip & 3) == 3) asm volatile("" ::: "memory");
        }
        bf16_t* R = REC + (rec0 + d) * 16384;
        if (cc < 64) {
#pragma unroll
            for (int i8 = 0; i8 < 8; ++i8) {
                u32x4 o; o.x = cvt_pk_bf16(x[i8 * 8], x[i8 * 8 + 1]); o.y = cvt_pk_bf16(x[i8 * 8 + 2], x[i8 * 8 + 3]); o.z = cvt_pk_bf16(x[i8 * 8 + 4], x[i8 * 8 + 5]); o.w = cvt_pk_bf16(x[i8 * 8 + 6], x[i8 * 8 + 7]);
                *(u32x4*)(R + cc * 64 + i8 * 8) = o;
            }
            const float gl = Gd[63];
            const bf16_t* kcol = KS + kpos(cc);
#pragma unroll 2
            for (int i8 = 0; i8 < 8; ++i8) {
                float kv[8];
#pragma unroll
                for (int q = 0; q < 8; ++q) { const int ip = (i8 >> 2) * 32 + (q >> 2) * 16 + (i8 & 3) * 4 + (q & 3), tok = d ? 63 - ip : ip; kv[q] = bf2f(kcol[tok * 64]) * __expf(gl - Gd[ip]); }
                u32x4 o; o.x = cvt_pk_bf16(kv[0], kv[1]); o.y = cvt_pk_bf16(kv[2], kv[3]); o.z = cvt_pk_bf16(kv[4], kv[5]); o.w = cvt_pk_bf16(kv[6], kv[7]);
                *(u32x4*)(R + 12288 + cc * 64 + i8 * 8) = o;
            }
        } else {
            { const int wp = kpos(cc - 64);
#pragma unroll
            for (int ip = 0; ip < 64; ++ip) R[4096 + ip * 64 + wp] = f2bf(-x[ip]); }
            const int ip = cc - 64; const float eg = __expf(Gd[ip]);
            EG[(rec0 + d) * 64 + ip] = eg;
            if (ip == 63) GL[rec0 + d] = eg;
        }
    }
    __syncthreads();
}

__device__ __forceinline__ void scan_chain(const Params& p, int b, int h, int d, bool need_ctx) {
    const bf16_t* REC = (const bf16_t*)(p.ws + OFF_BIG);
    const bf16_t* QC = (const bf16_t*)(p.ws + OFF_QC);
    const float *EG = (const float*)(p.ws + OFF_EG), *GL = (const float*)(p.ws + OFF_GL);
    bf16_t* O = (bf16_t*)(p.ws + (d ? OFF_VC : OFF_KC));
    const int tids = opaque_tid();
    const int lane = tids & 63, w = tids >> 6, l15 = lane & 15, quad = lane >> 4;
    f32x4 S[4];
#pragma unroll
    for (int kt = 0; kt < 4; ++kt) S[kt] = (f32x4){0.f, 0.f, 0.f, 0.f};
    for (int step = 0; step < 36; ++step) {
        const int c = d ? (step < 4 ? 3 - step : 39 - step) : step;
        const size_t rec = ((size_t)(b * 36 + c) * 6 + h) * 2 + d;
        const bf16_t* R = REC + rec * 16384;
        const size_t row0 = (size_t)b * TB + c * 64;
        const bf16_t* Rl = R + l15 * 64 + quad * 8;
        bf16x8 wf[4][2], qkf[4][2], kdf[4][2];
        u32x4 qraw[4][2]; float egv[4]; u32x2 uraw[4];
#pragma unroll
        for (int lt = 0; lt < 4; ++lt) {
            uraw[lt] = *(const u32x2*)(R + (16 * w + l15) * 64 + lt * 16 + quad * 4);
#pragma unroll
            for (int ks = 0; ks < 2; ++ks) wf[lt][ks] = ld8(Rl + 4096 + lt * 1024 + ks * 32);
        }
#pragma unroll
        for (int lt = 0; lt < 4; ++lt) {
            const int Lr = lt * 16 + l15, tok = d ? 63 - Lr : Lr;
            egv[lt] = EG[rec * 64 + Lr];
            const bf16_t* qrow = QC + (row0 + tok) * 384 + h * 64 + quad * 8;
#pragma unroll
            for (int ks = 0; ks < 2; ++ks) qraw[lt][ks] = *(const u32x4*)(qrow + ks * 32);
#pragma unroll
            for (int ls = 0; ls < 2; ++ls) qkf[lt][ls] = ld8(Rl + 8192 + lt * 1024 + ls * 32);
        }
#pragma unroll
        for (int kt = 0; kt < 4; ++kt)
#pragma unroll
            for (int ls = 0; ls < 2; ++ls) kdf[kt][ls] = ld8(Rl + 12288 + kt * 1024 + ls * 32);
        const float gl = GL[rec];
        asm volatile("" ::: "memory");
        bf16x8 Sb[2], Vb[2];
        Sb[0] = pack8(S[0], S[1]); Sb[1] = pack8(S[2], S[3]);
        f32x4 vn[4];
#pragma unroll
        for (int lt = 0; lt < 4; ++lt) {
            vn[lt] = (f32x4){bflo(uraw[lt].x), bfhi(uraw[lt].x), bflo(uraw[lt].y), bfhi(uraw[lt].y)};
#pragma unroll
            for (int ks = 0; ks < 2; ++ks) vn[lt] = mfma16(wf[lt][ks], Sb[ks], vn[lt]);
        }
        Vb[0] = pack8(vn[0], vn[1]); Vb[1] = pack8(vn[2], vn[3]);
        f32x4 o[4];
#pragma unroll
        for (int lt = 0; lt < 4; ++lt) {
            const float eg = egv[lt];
            o[lt] = (f32x4){0.f, 0.f, 0.f, 0.f};
#pragma unroll
            for (int ks = 0; ks < 2; ++ks) {
                const u32x4 qa = qraw[lt][ks];
                u32x4 qq; qq.x = cvt_pk_bf16(bflo(qa.x) * eg, bfhi(qa.x) * eg); qq.y = cvt_pk_bf16(bflo(qa.y) * eg, bfhi(qa.y) * eg);
                qq.z = cvt_pk_bf16(bflo(qa.z) * eg, bfhi(qa.z) * eg); qq.w = cvt_pk_bf16(bflo(qa.w) * eg, bfhi(qa.w) * eg);
                o[lt] = mfma16(__builtin_bit_cast(bf16x8, qq), Sb[ks], o[lt]);
            }
#pragma unroll
            for (int ls = 0; ls < 2; ++ls) o[lt] = mfma16(qkf[lt][ls], Vb[ls], o[lt]);
        }
#pragma unroll
        for (int kt = 0; kt < 4; ++kt) {
            S[kt] = S[kt] * gl;
#pragma unroll
            for (int ls = 0; ls < 2; ++ls) S[kt] = mfma16(kdf[kt][ls], Vb[ls], S[kt]);
        }
        if (need_ctx || c >= 4) {
#pragma unroll
            for (int lt = 0; lt < 4; ++lt)
#pragma unroll
                for (int r = 0; r < 4; ++r) { const int L = lt * 16 + quad * 4 + r, tok = d ? 63 - L : L; O[(row0 + tok) * 384 + h * 64 + 16 * w + l15] = f2bf(o[lt][r]); }
        }
    }
}

__device__ __forceinline__ void cout_phase(const Params& p, int layer, bool need_ctx) {
    const bf16_t *O0 = (const bf16_t*)(p.ws + OFF_KC), *O1 = (const bf16_t*)(p.ws + OFF_VC);
    bf16_t* Y = (bf16_t*)(p.ws + OFF_HN);
    const int tidc = opaque_tid();
    const int lane = tidc & 63, gw = blockIdx.x * 4 + (tidc >> 6), nw = gridDim.x * 4;
    const float wn = p.c_onorm[layer * 64 + lane];
    for (int row = gw; row < M; row += nw) {
        const int t = row % TB;
        if (!need_ctx && t < TC) continue;
#pragma unroll
        for (int hh = 0; hh < 6; ++hh) {
            const size_t oi = (size_t)row * 384 + hh * 64 + lane;
            const float o = bf2f(O0[oi]) + bf2f(O1[oi]);
            const float ss = wave_sum(o * o);
            const float gz = bf2f(Y[(size_t)row * D + 640 + hh * 64 + lane]);
            Y[(size_t)row * D + 640 + hh * 64 + lane] = f2bf(o * rsqrtf(ss * (1.f / 64.f) + EPS) * wn * gz);
        }
    }
}


#define DBG_NAN 0
__device__ __forceinline__ void dbg_scan(const void* ptr, size_t nbytes, bool is_bf16, unsigned* flag, unsigned code) {
    const u32x4* q = (const u32x4*)ptr; const size_t n = nbytes / 16;
    bool bad = false;
    for (size_t i = (size_t)blockIdx.x * 256 + threadIdx.x; i < n; i += (size_t)gridDim.x * 256) {
        const u32x4 v = q[i];
#pragma unroll
        for (int k = 0; k < 4; ++k) {
            const unsigned u = v[k];
            if (is_bf16) { if ((u & 0x7F80u) > (140u << 7) || (u & 0x7F800000u) > (140u << 23)) bad = true; }
            else if ((u & 0x7F800000u) > (140u << 23)) bad = true;
        }
    }
    if (bad) atomicMin(flag, code);
}

#define XB_TMO      128
#define XB_XCNT(j)  (256  + 64 * (j))
#define XB_XSUB(j)  (1280 + 64 * (j))
#define XB_XGEN(j)  (2304 + 64 * (j))
#define XB_TOP      3328
#define XB_TOPGEN   3392
#define XB_SPIN_CAP (1u << 21)
#define LAS __attribute__((address_space(3)))
__device__ __forceinline__ unsigned xb_ld(unsigned* p)              { return __hip_atomic_load(p, __ATOMIC_RELAXED, __HIP_MEMORY_SCOPE_AGENT); }
__device__ __forceinline__ unsigned xb_add(unsigned* p, unsigned v) { return __hip_atomic_fetch_add(p, v, __ATOMIC_RELAXED, __HIP_MEMORY_SCOPE_AGENT); }
__device__ __forceinline__ unsigned xb_xcc_id() { return (unsigned)__builtin_amdgcn_s_getreg((3 << 11) | 20) & 0xFu; }
#define XB_SPIN(cond, bar) do { unsigned _sp = 0; while (cond) { __builtin_amdgcn_s_sleep(1); \
    if ((++_sp & 255u) == 0u) { if (xb_ld(&(bar)[XB_TMO])) break; if (_sp > XB_SPIN_CAP) { atomicAdd(&(bar)[XB_TMO], 1u); break; } } } } while (0)
__device__ __forceinline__ void xcd_barrier_complete(unsigned* bar, unsigned x, unsigned& nloc, unsigned& nx) {
    const unsigned G = gridDim.x * gridDim.y * gridDim.z;
    unsigned sum, cnt, mine, sp = 0u;
    for (;;) {
        sum = 0u; cnt = 0u; mine = 0u;
#pragma unroll
        for (unsigned j = 0; j < 16; ++j) { const unsigned c = xb_ld(&bar[XB_XCNT(j)]); sum += c; cnt += (c > 0u) ? 1u : 0u; mine = (j == x) ? c : mine; }
        if (sum == G) break;
        __builtin_amdgcn_s_sleep(1);
        if ((++sp & 255u) == 0u) { if (xb_ld(&bar[XB_TMO])) break; if (sp > XB_SPIN_CAP) { atomicAdd(&bar[XB_TMO], 1u); break; } }
    }
    nloc = mine > 0u ? mine : 1u; nx = cnt > 0u ? cnt : 1u;
}
__device__ __forceinline__ void xcd_barrier(unsigned* bar, volatile LAS unsigned* st) {
    asm volatile("s_waitcnt vmcnt(0)" ::: "memory");
    __syncthreads();
    if (threadIdx.x == 0) {
        const unsigned x = xb_xcc_id();
        __builtin_amdgcn_s_waitcnt(0);
        unsigned nloc = st[0], nx = st[1];
        if (nloc == 0u) { xcd_barrier_complete(bar, x, nloc, nx); st[0] = nloc; st[1] = nx; }
        const unsigned old = xb_add(&bar[XB_XSUB(x)], 1u);
        const unsigned gen = old / nloc;
        if (old + 1u == (gen + 1u) * nloc) {
            __builtin_amdgcn_fence(__ATOMIC_RELEASE, "agent");
            asm volatile("s_waitcnt vmcnt(0)" ::: "memory");
            const unsigned og = xb_add(&bar[XB_TOP], 1u);
            const unsigned tg = og / nx;
            if (og + 1u == (tg + 1u) * nx) xb_add(&bar[XB_TOPGEN], 1u);
            else XB_SPIN(xb_ld(&bar[XB_TOPGEN]) == tg, bar);
            __builtin_amdgcn_fence(__ATOMIC_ACQUIRE, "agent");
            xb_add(&bar[XB_XGEN(x)], 1u);
            asm volatile("s_waitcnt vmcnt(0)" ::: "memory");
        } else {
            XB_SPIN(xb_ld(&bar[XB_XGEN(x)]) == gen, bar);
            __builtin_amdgcn_fence(__ATOMIC_ACQUIRE, "agent");
            asm volatile("s_waitcnt vmcnt(0)" ::: "memory");
        }
    }
    __syncthreads();
}

__device__ __forceinline__ void conv_jobs(const Params& p, int set, int first, int stride, char* lds) {
    bf16_t* Wb = (bf16_t*)(p.ws + OFF_W);
    const int j0 = (set == 2) ? 3 : 0, j1 = (set == 1) ? 3 : 6;
    const size_t lo = (set == 0) ? 0 : 1;
    for (int j = j0; j < j1; ++j) {
        const float* W; bf16_t* Wt; int K, N, Npad, mode;
        switch (j) {
            case 0: W = p.ffn1_w1 + lo * 1024 * 5632; Wt = Wb + WO_W1A; K = 1024; N = 5632; Npad = 5632; mode = 1; break;
            case 1: W = p.ffn1_w2 + lo * 2816 * 1024; Wt = Wb + WO_W2A; K = 2816; N = 1024; Npad = 1024; mode = 0; break;
            case 2: W = p.w_in + lo * 1024 * NIN; Wt = Wb + WO_WIN; K = 1024; N = NIN; Npad = NINP; mode = 0; break;
            case 3: W = p.w_out + lo * 1024 * 1024; Wt = Wb + WO_WOUT; K = 1024; N = 1024; Npad = 1024; mode = 0; break;
            case 4: W = p.ffn2_w1 + lo * 1024 * 5632; Wt = Wb + WO_W1B; K = 1024; N = 5632; Npad = 5632; mode = 1; break;
            default: W = p.ffn2_w2 + lo * 2816 * 1024; Wt = Wb + WO_W2B; K = 2816; N = 1024; Npad = 1024; mode = 0; break;
        }
        const int nt = (K >> 6) * (Npad >> 6);
#pragma unroll 1
        for (int t = first; t < nt; t += stride) convert_tile(W, K, N, Wt, mode, t, lds);
    }
}

__global__ void __launch_bounds__(256, 2) fwd_megakernel(Params p) {
    cg::grid_group grid = cg::this_grid();
    __shared__ __attribute__((aligned(16))) char lds[65536];
    volatile int& s_item = *(volatile int*)(lds + 65024);
    __shared__ uint4 xb_words;
    if (threadIdx.x == 0) { xb_words = make_uint4(0u, 0u, 0u, 0u); (void)xb_add((unsigned*)(p.ws + OFF_BAR) + XB_XCNT(xb_xcc_id()), 1u); }
    __syncthreads();

#pragma unroll 1
    for (int st = -1; st < 26; ++st) {
        const int layer = (st < 13) ? 0 : 1, s = (st < 0) ? -1 : st - layer * 13;
        const bool last = layer == 1, need_ctx = !last;
        bf16_t* Wb = (bf16_t*)(p.ws + OFF_W);
        float* H = (float*)(p.ws + OFF_H);
        bf16_t* HN = (bf16_t*)(p.ws + OFF_HN);
        bf16_t* BIG = (bf16_t*)(p.ws + OFF_BIG);
        const float* modL = (const float*)(p.ws + OFF_MOD) + (size_t)layer * 9 * 9216;
        switch (s) {
        case -1: {
            unsigned* CTR = (unsigned*)(p.ws + OFF_CTR);
            const int tid = opaque_tid();
#pragma unroll 1
            for (int it = blockIdx.x; it < 288; it += gridDim.x) mod_tile(p, it, lds);
            conv_jobs(p, 0, blockIdx.x, gridDim.x, lds);
            for (size_t i = (size_t)blockIdx.x * 256 + tid; i < (size_t)M * 256; i += (size_t)gridDim.x * 256) {
                const int row = (int)(i >> 8), c4 = (int)(i & 255), b = row / TB, t = row - b * TB;
                const float* src = (t < TC) ? p.ctx + ((size_t)b * TC + t) * D : p.x + ((size_t)b * TL + (t - TC)) * D;
                *(f32x4*)(H + (size_t)row * D + c4 * 4) = *(const f32x4*)(src + c4 * 4);
            }
        } break;
        case 0: case 3: case 10:
            norm_phase(p, layer, s == 10 ? 6 : s, last && s == 10);
            break;
        case 1: case 11: {
            EpiArgs e{}; e.obf = BIG;
            gemm256_phase<0>(HN, Wb + (s == 1 ? WO_W1A : WO_W1B), 1024, 44, last && s == 11, e, lds);
        } break;
        case 2: case 9: case 12: {
            EpiArgs e{}; e.H = H; e.gate = modL + (s == 2 ? 2 : (s == 9 ? 5 : 8)) * 1024; e.gscale = (s == 9) ? 1.0f : 0.5f;
            e.outp = (last && s == 12) ? p.out : nullptr;
            gemm_phase<1>(s == 9 ? HN : BIG, Wb + (s == 2 ? WO_W2A : (s == 9 ? WO_WOUT : WO_W2B)), s == 9 ? 1024 : 2816, 8, last && s >= 9, e, lds);
        } break;
        case 4: {
            EpiArgs e{}; e.obf = BIG; e.ldo = NINP;
            gemm256_phase<2>(HN, Wb + WO_WIN, 1024, 24, false, e, lds);
        } break;
        case 5:
            prep_phase(p, layer, lds);
            break;
        case 6: {
            unsigned* CTR = (unsigned*)(p.ws + OFF_CTR);
#pragma unroll 1
            for (;;) {
                if (threadIdx.x == 0) s_item = (int)atomicAdd(&CTR[layer], 1u);
                __syncthreads();
                const int it = s_item;
                __syncthreads();
                if (it >= 1728) break;
                const int h = it % 6, c = (it / 6) % 36, b = it / 216;
                chunk_prep(p, b, c, h, lds);
            }
        } break;
        case 7:
            if (blockIdx.x < 96) { const int d = blockIdx.x & 1, h = (blockIdx.x >> 1) % 6, b = blockIdx.x / 12; __builtin_amdgcn_s_setprio(3); scan_chain(p, b, h, d, need_ctx); __builtin_amdgcn_s_setprio(0); }
            else {
                conv_jobs(p, last ? 2 : 1, blockIdx.x - 96, gridDim.x - 96, lds);
                unsigned* CTR = (unsigned*)(p.ws + OFF_CTR);
                const float lam_init = last ? 0.35550906759f : 0.2f;
                const int nq = 64 + (need_ctx ? 8 : 0);
                const unsigned x0 = xb_xcc_id() & 7u;
#pragma unroll 1
                for (int v = 0; v < 8; ++v) {
                    const int xq = (int)((x0 + v) & 7u);
#pragma unroll 1
                    for (;;) {
                        if (threadIdx.x == 0) s_item = (int)atomicAdd(&CTR[8 + layer * 8 + xq], 1u);
                        __syncthreads();
                        const int q = s_item;
                        __syncthreads();
                        if (q >= nq) break;
                        const bool lat = q < 64; const int j = lat ? q : q - 64;
                        const int bh = xq + 8 * (lat ? (j >> 4) : (j >> 1)), qb = lat ? (j & 15) : (j & 1);
                        attnA_item(p, layer, bh >> 2, bh & 3, lat ? TC + qb * 128 : qb * 128, lat ? TB : TC, lam_init, lds);
                    }
                }
                {
                    const int nBl = 768, e2 = nBl + (need_ctx ? 96 : 0);
#pragma unroll 1
                    for (;;) {
                        if (threadIdx.x == 0) s_item = (int)atomicAdd(&CTR[4 + layer], 1u);
                        __syncthreads();
                        const int it = s_item;
                        __syncthreads();
                        if (it >= e2) break;
                        const bool lat = it < nBl; const int j = lat ? it : it - nBl;
                        const int qb = lat ? (j & 15) : (j & 1), hq = lat ? ((j >> 4) % 6) : ((j >> 1) % 6), b = lat ? (j / 96) : (j / 12);
                        attnB_item(p, layer, b, hq, lat ? TC + qb * 128 : qb * 128, lat, lds);
                    }
                }
            }
            break;
        default:
            cout_phase(p, layer, need_ctx);
            break;
        }
        if (st == -1) grid.sync();
        else if (st != 25) xcd_barrier((unsigned*)(p.ws + OFF_BAR), (volatile LAS unsigned*)&xb_words);
#if DBG_NAN
        {
            unsigned* flag = (unsigned*)(p.ws + OFF_CTR) + 32;
            const unsigned code = (unsigned)(st + 2);
#pragma unroll 1
            for (int q = 0; q < 3; ++q) {
                const void* ptr = nullptr; size_t nb = 0; bool isb = true; unsigned cd = code;
                if (q == 0) {
                    if (s == -1) { ptr = p.ws + OFF_MOD; nb = (size_t)2 * 9 * 9216 * 4; isb = false; }
                    else if (s == 0 || s == 3 || s == 10 || s == 6 || s == 8) { ptr = HN; nb = SZ_HN; }
                    else if (s == 1 || s == 11) { ptr = BIG; nb = (size_t)M * DFF * 2; }
                    else if (s == 2 || s == 9 || (s == 12 && !last)) { ptr = H; nb = SZ_H; isb = false; }
                    else if (s == 4) { ptr = BIG; nb = SZ_BIG; }
                    else if (s == 5) { ptr = p.ws + OFF_QC; nb = 3 * SZ_QC; }
                    else if (s == 7) { ptr = p.out; nb = (size_t)2 * M * 384 * 4; isb = false; }
                } else if (q == 1) {
                    if (s == 5) { ptr = p.out; nb = DO_END; }
                    else if (s == 6) { ptr = BIG; nb = SZ_BIG; cd = code + 30; }
                } else {
                    if (s == 5) { ptr = p.ws + OFF_G; nb = (size_t)M * 24 * 4; isb = false; }
                    else if (s == 6) { ptr = p.ws + OFF_EG; nb = (size_t)NREC * 65 * 4; isb = false; cd = code + 60; }
                }
                if (nb) dbg_scan(ptr, nb, isb, flag, cd);
            }
            if (s == 4) {
                const unsigned idx = blockIdx.x * 256 + threadIdx.x;
                const unsigned row = (idx * 2654435761u) % (unsigned)M, col = (idx * 40503u) % (unsigned)NINP;
                const bf16_t* ar = HN + (size_t)row * D; const bf16_t* br = Wb + WO_WIN + (size_t)col * 1024;
                float dot = 0.f;
                for (int k = 0; k < 1024; ++k) dot += bf2f(ar[k]) * bf2f(br[k]);
                const float cv = bf2f(BIG[(size_t)row * NINP + col]);
                if (!(fabsf(dot - cv) <= 0.05f + 0.02f * fabsf(dot))) atomicMin(flag + 1, 77u);
                if (fabsf(dot) > 100.f) atomicMin(flag + 1, 66u);
            }
            if (s == -1) {
                bf16_t* Wq = (bf16_t*)(p.ws + OFF_W);
#pragma unroll 1
                for (int q = 0; q < 6; ++q) {
                    const size_t o = (q == 0) ? WO_W1A : (q == 1) ? WO_W2A : (q == 2) ? WO_WIN : (q == 3) ? WO_WOUT : (q == 4) ? WO_W1B : WO_W2B;
                    const size_t n = (q == 0 || q == 4) ? E_W1 : (q == 1 || q == 5) ? E_W2 : (q == 2) ? E_WIN : E_WOUT;
                    dbg_scan(Wq + o, n * 2, true, flag + 1, 91u + q);
                }
            }
            grid.sync();
        }
#endif
    }
#if DBG_NAN
    {
        const unsigned f = *((volatile unsigned*)(p.ws + OFF_CTR) + 32);
        const unsigned f2 = *((volatile unsigned*)(p.ws + OFF_CTR) + 33);
        const float codev = (f2 != 9999u) ? 100.f * (float)f2 : ((f == 9999u) ? 0.f : 100.f * (float)f);
        for (size_t i = (size_t)blockIdx.x * 256 + threadIdx.x; i < (size_t)NB * TL * D; i += (size_t)gridDim.x * 256) {
            float v = p.out[i];
            if ((__float_as_uint(v) & 0x7F800000u) == 0x7F800000u) v = 500.f;
            if (codev != 0.f) v = codev;
            p.out[i] = v;
        }
    }
#endif
}

extern "C" void kernel_launch(void* const* d_in, const int* in_sizes, int n_in, void* d_out, int out_size, void* d_ws, size_t ws_size, hipStream_t stream) {
    (void)in_sizes; (void)n_in; (void)out_size;
    static int grid_blocks = 0;
    if (!grid_blocks) {
        int dev = 0, cus = 0, per_cu = 0;
        (void)hipGetDevice(&dev);
        (void)hipDeviceGetAttribute(&cus, hipDeviceAttributeMultiprocessorCount, dev);
        (void)hipOccupancyMaxActiveBlocksPerMultiprocessor(&per_cu, fwd_megakernel, 256, 0);
        if (per_cu > 2) per_cu = 2;
        if (per_cu < 1) per_cu = 1;
        grid_blocks = cus * per_cu;
    }
    if (ws_size < WS_NEED) { fprintf(stderr, "workspace too small: %zu < %zu\n", ws_size, (size_t)WS_NEED); }
    Params p{};
    const float** f = (const float**)&p;
    for (int i = 0; i < 23; ++i) f[i] = (const float*)d_in[i];
    p.out = (float*)d_out; p.ws = (char*)d_ws;
    (void)hipMemsetAsync((char*)d_ws + OFF_CTR, 0, WS_NEED - OFF_CTR, stream);
    void* args[] = {&p};
    hipError_t e = hipLaunchCooperativeKernel((void*)fwd_megakernel, dim3(grid_blocks), dim3(256), args, 0, stream);
    if (e != hipSuccess) fprintf(stderr, "cooperative launch failed: %s (grid %d)\n", hipGetErrorString(e), grid_blocks);
}
```

```cpp
#include <hip/hip_runtime.h>
#include <hip/hip_cooperative_groups.h>
#include <cstdio>
#include <cstdint>
namespace cg = cooperative_groups;

typedef unsigned short bf16_t;
typedef short bf16x8 __attribute__((ext_vector_type(8)));
typedef short bf16x4 __attribute__((ext_vector_type(4)));
typedef float f32x4 __attribute__((ext_vector_type(4)));
typedef unsigned u32x2 __attribute__((ext_vector_type(2)));
typedef unsigned u32x4 __attribute__((ext_vector_type(4)));

constexpr int D = 1024, NB = 8, TL = 2048, TC = 256, TB = 2304, M = NB * TB;
constexpr int DFF = 2816, NIN = 2968, NINP = 3072;
constexpr int NREC = NB * 36 * 6 * 2;
constexpr float EPS = 1e-6f;
constexpr float LOG2E = 1.4426950408889634f;

constexpr size_t SZ_H = (size_t)M * D * 4;
constexpr size_t SZ_HN = (size_t)M * D * 2;
constexpr size_t SZ_BIG = (size_t)M * NINP * 2;
constexpr size_t E_W1 = (size_t)5632 * 1024, E_W2 = (size_t)1024 * 2816, E_WIN = (size_t)NINP * 1024, E_WOUT = (size_t)1024 * 1024;
constexpr size_t SZ_W = (2 * E_W1 + 2 * E_W2 + E_WIN + E_WOUT) * 2;
constexpr size_t SZ_QC = (size_t)M * 384 * 2;
constexpr size_t OFF_H = 0;
constexpr size_t OFF_HN = OFF_H + SZ_H;
constexpr size_t OFF_BIG = OFF_HN + SZ_HN;
constexpr size_t OFF_W = OFF_BIG + SZ_BIG;
constexpr size_t OFF_QC = OFF_W + SZ_W;
constexpr size_t OFF_KC = OFF_QC + SZ_QC;
constexpr size_t OFF_VC = OFF_KC + SZ_QC;
constexpr size_t OFF_MOD = OFF_VC + SZ_QC;
constexpr size_t OFF_G = OFF_MOD + (size_t)2 * 9 * 9216 * 4;
constexpr size_t OFF_BETA = OFF_G + (size_t)M * 12 * 4;
constexpr size_t OFF_EG = OFF_BETA + (size_t)M * 12 * 4;
constexpr size_t OFF_GL = OFF_EG + (size_t)NREC * 64 * 4;
constexpr size_t OFF_CTR = OFF_GL + (size_t)NREC * 4;
constexpr size_t OFF_BAR = OFF_CTR + 256;
constexpr size_t WS_NEED = OFF_BAR + 3456 * 4;
static_assert(SZ_BIG == (size_t)NREC * 32768, "record region");
constexpr size_t WO_W1A = 0, WO_W2A = WO_W1A + E_W1, WO_WIN = WO_W2A + E_W2, WO_WOUT = WO_WIN + E_WIN, WO_W1B = WO_WOUT + E_WOUT, WO_W2B = WO_W1B + E_W1;
constexpr size_t DO_QA = 0, DO_KA = DO_QA + (size_t)NB * 4 * 2 * TB * 32 * 2, DO_VAT = DO_KA + (size_t)NB * 4 * 2 * TB * 32 * 2,
                 DO_QB = DO_VAT + (size_t)NB * 4 * 64 * TB * 2, DO_KB = DO_QB + (size_t)NB * 6 * TB * 64 * 2, DO_VBT = DO_KB + (size_t)NB * 2 * TB * 64 * 2,
                 DO_END = DO_VBT + (size_t)NB * 2 * 64 * TB * 2;
static_assert(DO_END <= (size_t)NB * TL * D * 4, "d_out scratch");
static_assert((size_t)2 * M * 384 * 4 <= (size_t)NB * TL * D * 4, "O scratch");

struct Params {
    const float *x, *c, *ctx, *c_ctx, *w_mod, *b_mod, *ffn1_w1, *ffn1_w2, *ffn2_w1, *ffn2_w2, *w_in, *w_out;
    const float *a_qnorm, *a_knorm, *a_lambda, *a_subln, *b_qnorm, *b_knorm, *b_sink, *c_conv, *c_A_log, *c_dt_bias, *c_onorm;
    float* out;
    char* ws;
};

typedef __bf16 bf16v2_t __attribute__((ext_vector_type(2)));
typedef float f32x2_t __attribute__((ext_vector_type(2)));
__device__ __forceinline__ unsigned cvt_pk_bf16(float lo, float hi) { const f32x2_t v = {lo, hi}; const bf16v2_t r = __builtin_convertvector(v, bf16v2_t); return __builtin_bit_cast(unsigned, r); }
__device__ __forceinline__ bf16_t f2bf(float f) { return (bf16_t)(cvt_pk_bf16(f, 0.f) & 0xffffu); }
__device__ __forceinline__ float bf2f(bf16_t h) { return __uint_as_float(((unsigned)h) << 16); }
__device__ __forceinline__ float bflo(unsigned u) { return __uint_as_float(u << 16); }
__device__ __forceinline__ float bfhi(unsigned u) { return __uint_as_float(u & 0xffff0000u); }
__device__ __forceinline__ float siluf(float v) { return v / (1.f + __expf(-v)); }
__device__ __forceinline__ f32x4 mfma16(bf16x8 a, bf16x8 b, f32x4 c) { return __builtin_amdgcn_mfma_f32_16x16x32_bf16(a, b, c, 0, 0, 0); }
__device__ __forceinline__ bf16x8 pack8(f32x4 a, f32x4 b) {
    u32x4 r; r.x = cvt_pk_bf16(a[0], a[1]); r.y = cvt_pk_bf16(a[2], a[3]); r.z = cvt_pk_bf16(b[0], b[1]); r.w = cvt_pk_bf16(b[2], b[3]);
    return __builtin_bit_cast(bf16x8, r);
}
__device__ __forceinline__ bf16x8 ld8(const bf16_t* p) { return *(const bf16x8*)p; }
__device__ __forceinline__ bf16x8 ld44(const bf16_t* p0, const bf16_t* p1) {
    u32x2 a = *(const u32x2*)p0, b = *(const u32x2*)p1; u32x4 r; r.x = a.x; r.y = a.y; r.z = b.x; r.w = b.y; return __builtin_bit_cast(bf16x8, r);
}
__device__ __forceinline__ float wave_sum(float v) {
    v += __shfl_xor(v, 32); v += __shfl_xor(v, 16); v += __shfl_xor(v, 8); v += __shfl_xor(v, 4); v += __shfl_xor(v, 2); v += __shfl_xor(v, 1); return v;
}
__device__ __forceinline__ float half_sum(float v) {
    v += __shfl_xor(v, 16); v += __shfl_xor(v, 8); v += __shfl_xor(v, 4); v += __shfl_xor(v, 2); v += __shfl_xor(v, 1); return v;
}
__device__ __forceinline__ float wave_max(float v) {
    v = fmaxf(v, __shfl_xor(v, 32)); v = fmaxf(v, __shfl_xor(v, 16)); v = fmaxf(v, __shfl_xor(v, 8)); v = fmaxf(v, __shfl_xor(v, 4)); v = fmaxf(v, __shfl_xor(v, 2)); v = fmaxf(v, __shfl_xor(v, 1)); return v;
}

__device__ __forceinline__ int opaque_tid() { int t = threadIdx.x; asm volatile("" : "+v"(t)); return t; }

__device__ __forceinline__ void convert_tile(const float* W, int K, int N, bf16_t* Wt, int mode, int tile, char* lds) {
    float* T = (float*)lds;
    const int nkt = K >> 6, tk = tile % nkt, tn = tile / nkt, k0 = tk * 64, n0 = tn * 128, tid = opaque_tid();
    {
        const int nl = (tid & 31) * 4, np = n0 + nl;
        int src = np;
        if (mode == 1) { const int g = np >> 5, w = np & 31; src = (w < 16) ? g * 16 + w : DFF + g * 16 + (w - 16); }
        const bool ok = (mode == 1) ? true : (np < N);
        f32x4 v[8];
#pragma unroll
        for (int i = 0; i < 8; ++i) { const int kl = (tid >> 5) + 8 * i; v[i] = (f32x4){0.f, 0.f, 0.f, 0.f}; if (ok) v[i] = *(const f32x4*)(W + (size_t)(k0 + kl) * N + src); }
#pragma unroll
        for (int i = 0; i < 8; ++i) { const int kl = (tid >> 5) + 8 * i; T[kl * 129 + nl] = v[i][0]; T[kl * 129 + nl + 1] = v[i][1]; T[kl * 129 + nl + 2] = v[i][2]; T[kl * 129 + nl + 3] = v[i][3]; }
    }
    __syncthreads();
    {
        const int kp = tid & 31;
#pragma unroll 4
        for (int i = 0; i < 16; ++i) { const int nl = (tid >> 5) + 8 * i; *(unsigned*)(Wt + (size_t)(n0 + nl) * K + k0 + 2 * kp) = cvt_pk_bf16(T[(2 * kp) * 129 + nl], T[(2 * kp + 1) * 129 + nl]); }
    }
    __syncthreads();
}

__device__ __forceinline__ void mod_tile(const Params& p, int item, char* lds) {
    float* sc = (float*)lds;
    const int tid = opaque_tid(), l = item / 144, c0 = (item % 144) * 64;
    for (int i = tid; i < 9 * 1024; i += 256) { const float v = (i < 8192) ? p.c[i] : p.c_ctx[i - 8192]; sc[i] = siluf(v); }
    __syncthreads();
    const int cgp = tid & 15, kg = tid >> 4;
    f32x4 acc[9];
#pragma unroll
    for (int r = 0; r < 9; ++r) acc[r] = (f32x4){0.f, 0.f, 0.f, 0.f};
    const float* Wp = p.w_mod + (size_t)l * 1024 * 9216 + c0 + cgp * 4;
#pragma unroll 16
    for (int kk = 0; kk < 64; ++kk) {
        const int k = kg * 64 + kk;
        const f32x4 w = *(const f32x4*)(Wp + (size_t)k * 9216);
#pragma unroll
        for (int r = 0; r < 9; ++r) acc[r] += w * sc[r * 1024 + k];
    }
    __syncthreads();
    float* red = (float*)lds;
#pragma unroll
    for (int r = 0; r < 9; ++r) *(f32x4*)(red + (kg * 9 + r) * 64 + cgp * 4) = acc[r];
    __syncthreads();
    float* MOD = (float*)(p.ws + OFF_MOD);
    for (int o = tid; o < 9 * 64; o += 256) {
        const int r = o >> 6, cc = o & 63; float s = 0.f;
#pragma unroll
        for (int g = 0; g < 16; ++g) s += red[(g * 9 + r) * 64 + cc];
        MOD[((size_t)l * 9 + r) * 9216 + c0 + cc] = s + p.b_mod[(size_t)l * 9216 + c0 + cc];
    }
    __syncthreads();
}

__device__ __forceinline__ void norm_phase(const Params& p, int layer, int midx, bool skip_ctx) {
    const float* H = (const float*)(p.ws + OFF_H);
    bf16_t* HN = (bf16_t*)(p.ws + OFF_HN);
    const float* MOD = (const float*)(p.ws + OFF_MOD) + (size_t)layer * 9 * 9216;
    const int tidn = opaque_tid();
    const int lane = tidn & 63, gw = blockIdx.x * 4 + (tidn >> 6), nw = gridDim.x * 4;
    for (int rb = gw * 9; rb < M; rb += nw * 9) {
        f32x4 v[9][4]; bool ok[9]; int mrr[9];
#pragma unroll
        for (int u = 0; u < 9; ++u) {
            const int row = rb + u;
            const int rr = row < M ? row : M - 1;
            const int b = rr / TB, t = rr - b * TB;
            ok[u] = (row < M) && !(skip_ctx && t < TC);
            mrr[u] = (t < TC) ? 8 : b;
            if (ok[u]) {
#pragma unroll
                for (int i = 0; i < 4; ++i) v[u][i] = *(const f32x4*)(H + (size_t)rr * D + lane * 4 + i * 256);
            }
        }
        int cur = -1; f32x4 s4[4], c4[4];
#pragma unroll
        for (int u = 0; u < 9; ++u) {
            if (!ok[u]) continue;
            if (mrr[u] != cur) {
                cur = mrr[u];
                const float* sh = MOD + (size_t)cur * 9216 + midx * 1024;
#pragma unroll
                for (int i = 0; i < 4; ++i) { s4[i] = *(const f32x4*)(sh + lane * 4 + i * 256); c4[i] = *(const f32x4*)(sh + 1024 + lane * 4 + i * 256); }
            }
        }
        asm volatile("" ::: "memory");
#pragma unroll
        for (int u = 0; u < 9; ++u) {
            if (!ok[u]) continue;
            if (mrr[u] != cur) {
                cur = mrr[u];
                const float* sh = MOD + (size_t)cur * 9216 + midx * 1024;
#pragma unroll
                for (int i = 0; i < 4; ++i) { s4[i] = *(const f32x4*)(sh + lane * 4 + i * 256); c4[i] = *(const f32x4*)(sh + 1024 + lane * 4 + i * 256); }
            }
            float ss = 0.f;
#pragma unroll
            for (int i = 0; i < 4; ++i) ss += v[u][i][0] * v[u][i][0] + v[u][i][1] * v[u][i][1] + v[u][i][2] * v[u][i][2] + v[u][i][3] * v[u][i][3];
            const float r = rsqrtf(wave_sum(ss) * (1.f / 1024.f) + EPS);
            const int row = rb + u;
#pragma unroll
            for (int i = 0; i < 4; ++i) {
                u32x2 o; o.x = cvt_pk_bf16(v[u][i][0] * r * (1.f + c4[i][0]) + s4[i][0], v[u][i][1] * r * (1.f + c4[i][1]) + s4[i][1]);
                o.y = cvt_pk_bf16(v[u][i][2] * r * (1.f + c4[i][2]) + s4[i][2], v[u][i][3] * r * (1.f + c4[i][3]) + s4[i][3]);
                *(u32x2*)(HN + (size_t)row * D + lane * 4 + i * 256) = o;
            }
        }
    }
}

struct EpiArgs { bf16_t* obf; float* H; float* outp; const float* gate; float gscale; int ldo; };
template <int EPI>
__device__ __forceinline__ void gemm_phase(const bf16_t* A, const bf16_t* Bt, int K, int nN, bool skip_ctx, const EpiArgs e, char* lds) {
    const int tid = opaque_tid(), lane = tid & 63, w = tid >> 6, wm = w >> 1, wn = w & 1, l15 = lane & 15, quad = lane >> 4;
    const int ntm = skip_ctx ? 128 : 144, ntiles = ntm * nN, nk = K >> 6;
    const int woff = (tid >> 3) * 128 + ((((tid & 7) ^ ((tid >> 4) & 7))) << 4);
    int aoff[4][2], boff[4][2];
#pragma unroll
    for (int t = 0; t < 4; ++t)
#pragma unroll
        for (int ks = 0; ks < 2; ++ks) {
            aoff[t][ks] = (wm * 64 + t * 16 + l15) * 128 + ((((ks * 4 + quad) ^ (l15 >> 1))) << 4);
            boff[t][ks] = 16384 + (wn * 64 + t * 16 + l15) * 128 + ((((ks * 4 + quad) ^ (l15 >> 1))) << 4);
        }
    const int xcd = blockIdx.x & 7, lblk = blockIdx.x >> 3, nlb = gridDim.x >> 3, ntmx = ntm >> 3, ntx = ntmx * nN, nfull = (nN >> 3) << 3;
    (void)ntiles;
    for (int lt = lblk; lt < ntx; lt += nlb) {
        int tml, tn;
        if (lt < ntmx * nfull) { const int g = lt / (ntmx * 8), rem = lt - g * (ntmx * 8); tml = rem >> 3; tn = g * 8 + (rem & 7); }
        else { const int l2 = lt - ntmx * nfull, gw = nN - nfull; tml = l2 / gw; tn = nfull + (l2 - tml * gw); }
        const int tmi = xcd * ntmx + tml;
        const int tm = skip_ctx ? (tmi >> 4) * 18 + 2 + (tmi & 15) : tmi;
        const int m0 = tm * 128, n0 = tn * 128;
        const bf16_t* ag = A + (size_t)(m0 + (tid >> 3)) * K + (tid & 7) * 8;
        const bf16_t* bg = Bt + (size_t)(n0 + (tid >> 3)) * K + (tid & 7) * 8;
        f32x4 acc[4][4];
#pragma unroll
        for (int i = 0; i < 4; ++i)
#pragma unroll
            for (int j = 0; j < 4; ++j) acc[i][j] = (f32x4){0.f, 0.f, 0.f, 0.f};
        u32x4 ra0[4], rb0[4], ra1[4], rb1[4];
#define GLOAD(RA, RB, KT) do { _Pragma("unroll") for (int i = 0; i < 4; ++i) { RA[i] = *(const u32x4*)(ag + (size_t)i * 32 * K + (KT) * 64); RB[i] = *(const u32x4*)(bg + (size_t)i * 32 * K + (KT) * 64); } } while (0)
#define LSTORE(RA, RB, BUF) do { _Pragma("unroll") for (int i = 0; i < 4; ++i) { *(u32x4*)((BUF) + woff + i * 4096) = RA[i]; *(u32x4*)((BUF) + 16384 + woff + i * 4096) = RB[i]; } } while (0)
#define COMPUTE(BUF) do { _Pragma("unroll") for (int ks = 0; ks < 2; ++ks) { bf16x8 af[4], bfr[4]; \
            _Pragma("unroll") for (int t = 0; t < 4; ++t) { af[t] = *(const bf16x8*)((BUF) + aoff[t][ks]); bfr[t] = *(const bf16x8*)((BUF) + boff[t][ks]); } \
            __builtin_amdgcn_s_setprio(1); \
            _Pragma("unroll") for (int mt = 0; mt < 4; ++mt) _Pragma("unroll") for (int nt = 0; nt < 4; ++nt) acc[mt][nt] = mfma16(bfr[nt], af[mt], acc[mt][nt]); \
            __builtin_amdgcn_s_setprio(0); } } while (0)
        GLOAD(ra0, rb0, 0);
        GLOAD(ra1, rb1, 1);
        LSTORE(ra0, rb0, lds);
        __syncthreads();
        for (int kt = 0; kt < nk; kt += 2) {
            if (kt + 2 < nk) GLOAD(ra0, rb0, kt + 2);
            COMPUTE(lds);
            LSTORE(ra1, rb1, lds + 32768);
            __syncthreads();
            if (kt + 3 < nk) GLOAD(ra1, rb1, kt + 3);
            COMPUTE(lds + 32768);
            if (kt + 2 < nk) LSTORE(ra0, rb0, lds);
            __syncthreads();
        }
#undef GLOAD
#undef LSTORE
#undef COMPUTE
#pragma unroll
        for (int mt = 0; mt < 4; ++mt) {
            const int row = m0 + wm * 64 + mt * 16 + l15;
            const int b = row / TB, t = row - b * TB;
            if (EPI == 0) {
#pragma unroll
                for (int nt = 0; nt < 4; nt += 2) {
                    const int hc = ((n0 + wn * 64 + nt * 16) >> 1) + quad * 4;
                    const f32x4 g = acc[mt][nt], u = acc[mt][nt + 1];
                    u32x2 o; o.x = cvt_pk_bf16(siluf(g[0]) * u[0], siluf(g[1]) * u[1]); o.y = cvt_pk_bf16(siluf(g[2]) * u[2], siluf(g[3]) * u[3]);
                    *(u32x2*)(e.obf + (size_t)row * DFF + hc) = o;
                }
            } else if (EPI == 2) {
#pragma unroll
                for (int nt = 0; nt < 4; ++nt) {
                    const int col = n0 + wn * 64 + nt * 16 + quad * 4;
                    u32x2 o; o.x = cvt_pk_bf16(acc[mt][nt][0], acc[mt][nt][1]); o.y = cvt_pk_bf16(acc[mt][nt][2], acc[mt][nt][3]);
                    *(u32x2*)(e.obf + (size_t)row * e.ldo + col) = o;
                }
            } else {
                const int mr = (t < TC) ? 8 : b;
                const float* gp = e.gate + (size_t)mr * 9216;
#pragma unroll
                for (int nt = 0; nt < 4; ++nt) {
                    const int col = n0 + wn * 64 + nt * 16 + quad * 4;
                    const f32x4 gv = *(const f32x4*)(gp + col);
                    f32x4 h = *(const f32x4*)(e.H + (size_t)row * D + col);
                    h += (gv * e.gscale) * acc[mt][nt];
                    if (e.outp == nullptr) *(f32x4*)(e.H + (size_t)row * D + col) = h;
                    else if (t >= TC) *(f32x4*)(e.outp + ((size_t)b * TL + (t - TC)) * D + col) = h;
                }
            }
        }
    }
}

template <int EPI>
__device__ __forceinline__ void gemm256_phase(const bf16_t* A, const bf16_t* Bt, int K, int nN, bool skip_ctx, const EpiArgs e, char* lds) {
    const int tid = opaque_tid(), lane = tid & 63, w = tid >> 6, wm = w >> 1, wn = w & 1, l15 = lane & 15, quad = lane >> 4;
    const int nk = K >> 5;
    const int gsel_w = (tid >> 4) & 3, gw = (gsel_w == 0) ? 0 : (gsel_w == 1) ? 2 : (gsel_w == 2) ? 3 : 1;
    const int woff = (tid >> 2) * 64 + (((tid & 3) ^ gw) << 4);
    const int gsel_r = (l15 >> 2) & 3, gr = (gsel_r == 0) ? 0 : (gsel_r == 1) ? 2 : (gsel_r == 2) ? 3 : 1;
    const int aoff = (wm * 128 + l15) * 64 + ((quad ^ gr) << 4);
    const int boff = 16384 + (wn * 64 + l15) * 64 + ((quad ^ gr) << 4);
    const int ntm = skip_ctx ? 64 : 72;
    const int xcd = blockIdx.x & 7, lblk = blockIdx.x >> 3, nlb = gridDim.x >> 3, ntmx = ntm >> 3, ntx = ntmx * nN, nfull = (nN >> 3) << 3;
    for (int lt = lblk; lt < ntx; lt += nlb) {
        int tml, tn;
        if (lt < ntmx * nfull) { const int g = lt / (ntmx * 8), rem = lt - g * (ntmx * 8); tml = rem >> 3; tn = g * 8 + (rem & 7); }
        else { const int l2 = lt - ntmx * nfull, gwd = nN - nfull; tml = l2 / gwd; tn = nfull + (l2 - tml * gwd); }
        const int tmi = xcd * ntmx + tml;
        const int tm = skip_ctx ? (tmi >> 3) * 9 + 1 + (tmi & 7) : tmi;
        const int m0 = tm * 256, n0 = tn * 128;
        const bf16_t* ag = A + (size_t)(m0 + (tid >> 2)) * K + (tid & 3) * 8;
        const bf16_t* bg = Bt + (size_t)(n0 + (tid >> 2)) * K + (tid & 3) * 8;
        f32x4 acc[8][4];
#pragma unroll
        for (int i = 0; i < 8; ++i)
#pragma unroll
            for (int j = 0; j < 4; ++j) acc[i][j] = (f32x4){0.f, 0.f, 0.f, 0.f};
        u32x4 ra0[4], rb0[2], ra1[4], rb1[2];
#define G2LOAD(RA, RB, KT) do { _Pragma("unroll") for (int i = 0; i < 4; ++i) RA[i] = *(const u32x4*)(ag + (size_t)i * 64 * K + (KT) * 32); \
                        _Pragma("unroll") for (int i = 0; i < 2; ++i) RB[i] = *(const u32x4*)(bg + (size_t)i * 64 * K + (KT) * 32); } while (0)
#define L2STORE(RA, RB, BUF) do { _Pragma("unroll") for (int i = 0; i < 4; ++i) *(u32x4*)((BUF) + woff + i * 4096) = RA[i]; \
                          _Pragma("unroll") for (int i = 0; i < 2; ++i) *(u32x4*)((BUF) + 16384 + woff + i * 4096) = RB[i]; } while (0)
#define C2MPUTE(BUF) do { bf16x8 bfr[4], af[4]; \
            _Pragma("unroll") for (int t = 0; t < 4; ++t) { bfr[t] = *(const bf16x8*)((BUF) + boff + t * 1024); af[t] = *(const bf16x8*)((BUF) + aoff + t * 1024); } \
            __builtin_amdgcn_s_setprio(1); \
            _Pragma("unroll") for (int mt = 0; mt < 4; ++mt) _Pragma("unroll") for (int nt = 0; nt < 4; ++nt) acc[mt][nt] = mfma16(bfr[nt], af[mt], acc[mt][nt]); \
            __builtin_amdgcn_s_setprio(0); \
            _Pragma("unroll") for (int t = 0; t < 4; ++t) af[t] = *(const bf16x8*)((BUF) + aoff + (4 + t) * 1024); \
            __builtin_amdgcn_s_setprio(1); \
            _Pragma("unroll") for (int mt = 0; mt < 4; ++mt) _Pragma("unroll") for (int nt = 0; nt < 4; ++nt) acc[4 + mt][nt] = mfma16(bfr[nt], af[mt], acc[4 + mt][nt]); \
            __builtin_amdgcn_s_setprio(0); } while (0)
        G2LOAD(ra0, rb0, 0);
        G2LOAD(ra1, rb1, 1);
        L2STORE(ra0, rb0, lds);
        __syncthreads();
        for (int kt = 0; kt < nk; kt += 2) {
            if (kt + 2 < nk) G2LOAD(ra0, rb0, kt + 2);
            C2MPUTE(lds);
            L2STORE(ra1, rb1, lds + 24576);
            __syncthreads();
            if (kt + 3 < nk) G2LOAD(ra1, rb1, kt + 3);
            C2MPUTE(lds + 24576);
            if (kt + 2 < nk) L2STORE(ra0, rb0, lds);
            __syncthreads();
        }
#undef G2LOAD
#undef L2STORE
#undef C2MPUTE
#pragma unroll
        for (int mt = 0; mt < 8; ++mt) {
            const int row = m0 + wm * 128 + mt * 16 + l15;
            if (EPI == 0) {
#pragma unroll
                for (int nt = 0; nt < 4; nt += 2) {
                    const int hc = ((n0 + wn * 64 + nt * 16) >> 1) + quad * 4;
                    const f32x4 g = acc[mt][nt], u = acc[mt][nt + 1];
                    u32x2 o; o.x = cvt_pk_bf16(siluf(g[0]) * u[0], siluf(g[1]) * u[1]); o.y = cvt_pk_bf16(siluf(g[2]) * u[2], siluf(g[3]) * u[3]);
                    *(u32x2*)(e.obf + (size_t)row * DFF + hc) = o;
                }
            } else {
#pragma unroll
                for (int nt = 0; nt < 4; ++nt) {
                    const int col = n0 + wn * 64 + nt * 16 + quad * 4;
                    u32x2 o; o.x = cvt_pk_bf16(acc[mt][nt][0], acc[mt][nt][1]); o.y = cvt_pk_bf16(acc[mt][nt][2], acc[mt][nt][3]);
                    *(u32x2*)(e.obf + (size_t)row * e.ldo + col) = o;
                }
            }
        }
    }
}

__device__ __forceinline__ int kpos(int x) { return (x & 32) + (((x & 15) >> 2) * 8 + ((x >> 4) & 1) * 4 + (x & 3)); }
__device__ __forceinline__ size_t vt_off(int dv, int t) { const int w = t & 31; return ((size_t)(t >> 5) * 64 + dv) * 32 + (((w & 15) >> 2) * 8 + ((w >> 4) & 1) * 4 + (w & 3)); }
__device__ __forceinline__ void ld8f(const bf16_t* p, float (&x)[8]) {
    const u32x4 v = *(const u32x4*)p;
    x[0] = bflo(v.x); x[1] = bfhi(v.x); x[2] = bflo(v.y); x[3] = bfhi(v.y); x[4] = bflo(v.z); x[5] = bfhi(v.z); x[6] = bflo(v.w); x[7] = bfhi(v.w);
}
__device__ __forceinline__ void st8f(bf16_t* p, const float (&y)[8]) {
    u32x4 o; o.x = cvt_pk_bf16(y[0], y[1]); o.y = cvt_pk_bf16(y[2], y[3]); o.z = cvt_pk_bf16(y[4], y[5]); o.w = cvt_pk_bf16(y[6], y[7]);
    *(u32x4*)p = o;
}
__device__ __forceinline__ void prep_phase(const Params& p, int layer, char* lds) {
    const bf16_t* P = (const bf16_t*)(p.ws + OFF_BIG);
    char* dob = (char*)p.out;
    bf16_t *QA = (bf16_t*)(dob + DO_QA), *KA = (bf16_t*)(dob + DO_KA), *VAT = (bf16_t*)(dob + DO_VAT), *QB = (bf16_t*)(dob + DO_QB), *KB = (bf16_t*)(dob + DO_KB), *VBT = (bf16_t*)(dob + DO_VBT);
    bf16_t *QC = (bf16_t*)(p.ws + OFF_QC), *KC = (bf16_t*)(p.ws + OFF_KC), *VC = (bf16_t*)(p.ws + OFF_VC);
    bf16_t* Y = (bf16_t*)(p.ws + OFF_HN);
    float *G = (float*)(p.ws + OFF_G), *BETA = (float*)(p.ws + OFF_BETA);
    const float *aq = p.a_qnorm + layer * 32, *ak = p.a_knorm + layer * 32, *bq = p.b_qnorm + layer * 64, *bk = p.b_knorm + layer * 64;
    const float *cw = p.c_conv + (size_t)layer * 5 * 1152, *alog = p.c_A_log + layer * 12, *dtb = p.c_dt_bias + layer * 12;
    const int tid = opaque_tid(), lane = tid & 63, w = tid >> 6;
    unsigned* TT = (unsigned*)lds;
    float* CW = (float*)(lds + 12544);
    float* RA = (float*)(lds + 12544 + 23040);
    float* RB = RA + 1024;
    for (int i = tid; i < 5 * 1152; i += 256) CW[i] = cw[i];
    for (int i = tid; i < 512; i += 256) { const int pos = i >> 3, f = i & 7; float sn, cs; sincosf((float)pos * exp2f(-(float)f * (13.287712379549449f / 8.f)), &sn, &cs); RA[i * 2] = cs; RA[i * 2 + 1] = sn; }
    for (int i = tid; i < 1024; i += 256) { const int pos = i >> 4, f = i & 15; float sn, cs; sincosf((float)pos * exp2f(-(float)f * (13.287712379549449f / 16.f)), &sn, &cs); RB[i * 2] = cs; RB[i * 2 + 1] = sn; }
    __syncthreads();
    for (int tile = blockIdx.x; tile < M / 16; tile += gridDim.x) {
        const int row0 = tile * 16, b = row0 / TB, t0 = row0 - b * TB;
        const bool is_ctx = t0 < TC;
        for (int idx = tid; idx < 16 * 192; idx += 256) {
            const int tok = idx / 192, cp = idx - tok * 192, c2 = cp * 2;
            const int col = (c2 < 256) ? 512 + c2 : 1280 + (c2 - 256);
            TT[tok * 193 + cp] = *(const unsigned*)(P + (size_t)(row0 + tok) * NINP + col);
        }
#pragma unroll 2
        for (int task = w; task < 32; task += 4) {
            const int tok = task >> 1, isB = task & 1, row = row0 + tok, t = t0 + tok, tl = t - TC;
            const int prow_pos = tl >> 6, pcol_pos = tl & 63;
            const bf16_t* prow = P + (size_t)row * NINP;
            float x[8], y[8];
            if (!isB) {
                const int c = lane;
                const bool isq = c < 32; const int hh = (c >> 3) & 3, mp = (c >> 2) & 1, cc = c & 3;
                ld8f(prow + c * 8, x);
                float ss = 0.f;
#pragma unroll
                for (int j = 0; j < 8; ++j) ss += x[j] * x[j];
                ss += __shfl_xor(ss, 1); ss += __shfl_xor(ss, 2);
                const float r = rsqrtf(ss * (1.f / 32.f) + EPS);
                const float* wn = (isq ? aq : ak) + cc * 8;
#pragma unroll
                for (int j = 0; j < 8; ++j) y[j] = x[j] * r * wn[j];
                if (!is_ctx) {
                    const float* tb = RA + ((cc < 2 ? prow_pos : pcol_pos) * 8) * 2;
#pragma unroll
                    for (int j = 0; j < 8; ++j) {
                        const float pr = __shfl_xor(y[j], 1), cs = tb[j * 2], sn = tb[j * 2 + 1];
                        y[j] = y[j] * cs + pr * ((cc & 1) ? sn : -sn);
                    }
                }
                st8f((isq ? QA : KA) + ((size_t)((b * 4 + hh) * 2 + mp) * TB + t) * 32 + cc * 8, y);
            } else {
                const int c = lane;
                const bool isq = c < 48; const int hh = isq ? (c >> 3) : ((c - 48) >> 3), cc = c & 7;
                ld8f(prow + 768 + c * 8, x);
                float ss = 0.f;
#pragma unroll
                for (int j = 0; j < 8; ++j) ss += x[j] * x[j];
                ss += __shfl_xor(ss, 1); ss += __shfl_xor(ss, 2); ss += __shfl_xor(ss, 4);
                const float r = rsqrtf(ss * (1.f / 64.f) + EPS);
                const float* wn = (isq ? bq : bk) + cc * 8;
#pragma unroll
                for (int j = 0; j < 8; ++j) y[j] = x[j] * r * wn[j];
                if (!is_ctx) {
                    const float* tb = RB + ((cc < 4 ? prow_pos : pcol_pos) * 16 + (cc & 1) * 8) * 2;
#pragma unroll
                    for (int j = 0; j < 8; ++j) {
                        const float pr = __shfl_xor(y[j], 2), cs = tb[j * 2], sn = tb[j * 2 + 1];
                        y[j] = y[j] * cs + pr * ((cc & 2) ? sn : -sn);
                    }
                }
                st8f((isq ? QB + ((size_t)(b * 6 + hh) * TB + t) * 64 : KB + ((size_t)(b * 2 + hh) * TB + t) * 64) + cc * 8, y);
            }
        }
#pragma unroll 2
        for (int task = w; task < 48; task += 4) {
            const int tok = task / 3, cidx = (task - tok * 3) * 64 + lane, row = row0 + tok, t = t0 + tok;
            if (cidx < 144) {
                const int part = cidx / 48, hh = (cidx - part * 48) >> 3, cc = cidx & 7;
                const int ts = is_ctx ? 0 : TC, len = is_ctx ? TC : TL, tq = t - ts;
                float a[8];
#pragma unroll
                for (int j = 0; j < 8; ++j) a[j] = 0.f;
#pragma unroll
                for (int i = 0; i < 5; ++i) {
                    const int tt = tq + i - 2;
                    if (tt >= 0 && tt < len) {
                        float x[8]; ld8f(P + (size_t)(row + i - 2) * NINP + 1408 + cidx * 8, x);
                        const f32x4 w0 = *(const f32x4*)(CW + i * 1152 + cidx * 8), w1 = *(const f32x4*)(CW + i * 1152 + cidx * 8 + 4);
                        a[0] += w0[0] * x[0]; a[1] += w0[1] * x[1]; a[2] += w0[2] * x[2]; a[3] += w0[3] * x[3];
                        a[4] += w1[0] * x[4]; a[5] += w1[1] * x[5]; a[6] += w1[2] * x[6]; a[7] += w1[3] * x[7];
                    }
                }
                float ss = 0.f;
#pragma unroll
                for (int j = 0; j < 8; ++j) { a[j] = siluf(a[j]); ss += a[j] * a[j]; }
                ss += __shfl_xor(ss, 1); ss += __shfl_xor(ss, 2); ss += __shfl_xor(ss, 4);
                if (part < 2) {
                    const float r = rsqrtf(ss + EPS) * (part == 0 ? 0.125f : 1.f);
#pragma unroll
                    for (int j = 0; j < 8; ++j) a[j] *= r;
                }
                if (part == 2) st8f(VC + (size_t)row * 384 + hh * 64 + cc * 8, a);
                else {
                    bf16_t* dst = (part == 0 ? QC : KC) + (size_t)row * 384 + hh * 64;
                    u32x2 o0, o1; o0.x = cvt_pk_bf16(a[0], a[1]); o0.y = cvt_pk_bf16(a[2], a[3]); o1.x = cvt_pk_bf16(a[4], a[5]); o1.y = cvt_pk_bf16(a[6], a[7]);
                    *(u32x2*)(dst + kpos(cc * 8)) = o0; *(u32x2*)(dst + kpos(cc * 8 + 4)) = o1;
                }
            }
        }
        for (int idx = tid; idx < 16 * 24; idx += 256) {
            const int tok = idx / 24, j = idx - tok * 24, row = row0 + tok;
            if (j < 12) {
                const float a = bf2f(P[(size_t)row * NINP + 2944 + j]) + dtb[j];
                const float sp = fmaxf(a, 0.f) + log1pf(__expf(-fabsf(a)));
                G[(size_t)row * 12 + j] = -__expf(alog[j]) * sp;
            } else {
                const float bb = bf2f(P[(size_t)row * NINP + 2956 + (j - 12)]);
                BETA[(size_t)row * 12 + (j - 12)] = 1.f / (1.f + __expf(-bb));
            }
        }
        for (int idx = tid; idx < 16 * 48; idx += 256) {
            const int tok = idx / 48, cp = idx - tok * 48;
            float x[8]; ld8f(P + (size_t)(row0 + tok) * NINP + 2560 + cp * 8, x);
#pragma unroll
            for (int j = 0; j < 8; ++j) x[j] = siluf(x[j]);
            st8f(Y + (size_t)(row0 + tok) * D + 640 + cp * 8, x);
        }
        __syncthreads();
        {
            const int tok = tid & 15;
            for (int cidx = tid >> 4; cidx < 384; cidx += 16) {
                const unsigned v2 = TT[tok * 193 + (cidx >> 1)];
                const bf16_t v = (cidx & 1) ? (bf16_t)(v2 >> 16) : (bf16_t)(v2 & 0xffff);
                if (cidx < 256) VAT[(size_t)(b * 4 + (cidx >> 6)) * 64 * TB + vt_off(cidx & 63, t0 + tok)] = v;
                else { const int c2 = cidx - 256; VBT[(size_t)(b * 2 + (c2 >> 6)) * 64 * TB + vt_off(c2 & 63, t0 + tok)] = v; }
            }
        }
        __syncthreads();
    }
}

template <int DQK>
__device__ __forceinline__ void attn_wave(const bf16_t* Q, const bf16_t* Kp, const bf16_t* VT, int qt0, int kbeg, int kend, int k2beg, int k2end,
                                          float c1, float c2, f32x4 (&acc)[2][4], float (&lsum)[2], int lane) {
    constexpr int KS = DQK / 32;
    const int l15 = lane & 15, quad = lane >> 4;
    bf16x8 qf[2][KS];
#pragma unroll
    for (int qt = 0; qt < 2; ++qt)
#pragma unroll
        for (int ks = 0; ks < KS; ++ks) qf[qt][ks] = ld8(Q + (size_t)(qt0 + qt * 16 + l15) * DQK + ks * 32 + quad * 8);
    const bf16_t* kbase = Kp + (size_t)l15 * DQK + quad * 8;
    const bf16_t* vbase = VT + (size_t)l15 * 32 + quad * 8;
#pragma unroll 1
    for (int rg = 0; rg < 2; ++rg) {
        const int kb0 = rg ? k2beg : kbeg, kb1 = rg ? k2end : kend;
        const bool band = rg != 0;
        if (kb0 >= kb1) continue;
        bf16x8 kf[2][KS], vf[4];
#pragma unroll
        for (int kt = 0; kt < 2; ++kt)
#pragma unroll
            for (int ks = 0; ks < KS; ++ks) kf[kt][ks] = ld8(kbase + (size_t)(kb0 + kt * 16) * DQK + ks * 32);
#pragma unroll
        for (int dt = 0; dt < 4; ++dt) vf[dt] = ld8(vbase + (size_t)(kb0 >> 5) * 2048 + dt * 512);
#pragma unroll 1
        for (int kb = kb0; kb < kb1; kb += 32) {
            const int kn = (kb + 32 < kb1) ? kb + 32 : kb;
            bf16x8 kfn[2][KS], vfn[4];
#pragma unroll
            for (int kt = 0; kt < 2; ++kt)
#pragma unroll
                for (int ks = 0; ks < KS; ++ks) kfn[kt][ks] = ld8(kbase + (size_t)(kn + kt * 16) * DQK + ks * 32);
#pragma unroll
            for (int dt = 0; dt < 4; ++dt) vfn[dt] = ld8(vbase + (size_t)(kn >> 5) * 2048 + dt * 512);
#pragma unroll
            for (int qt = 0; qt < 2; ++qt) {
                f32x4 s[2];
#pragma unroll
                for (int kt = 0; kt < 2; ++kt) {
                    s[kt] = (f32x4){0.f, 0.f, 0.f, 0.f};
#pragma unroll
                    for (int ks = 0; ks < KS; ++ks) s[kt] = mfma16(kf[kt][ks], qf[qt][ks], s[kt]);
                }
                float ps = 0.f;
#pragma unroll
                for (int kt = 0; kt < 2; ++kt)
#pragma unroll
                    for (int j = 0; j < 4; ++j) {
                        float pv = __builtin_amdgcn_exp2f(s[kt][j] * c1 - c2);
                        if (band) {
                            const int dd = (qt0 + qt * 16 + l15) - (kb + kt * 16 + quad * 4 + j);
                            if (dd > 128 || dd < -128) pv = 0.f;
                        }
                        s[kt][j] = pv; ps += pv;
                    }
                lsum[qt] += ps;
                const bf16x8 pf = pack8(s[0], s[1]);
#pragma unroll
                for (int dt = 0; dt < 4; ++dt) acc[qt][dt] = mfma16(vf[dt], pf, acc[qt][dt]);
            }
#pragma unroll
            for (int kt = 0; kt < 2; ++kt)
#pragma unroll
                for (int ks = 0; ks < KS; ++ks) kf[kt][ks] = kfn[kt][ks];
#pragma unroll
            for (int dt = 0; dt < 4; ++dt) vf[dt] = vfn[dt];
        }
    }
}

__device__ __forceinline__ void attnA_item(const Params& p, int layer, int b, int h, int qt_first  , int kend, float lam_init, char* lds) {
    char* dob = (char*)p.out;
    const bf16_t *QA = (const bf16_t*)(dob + DO_QA), *KA = (const bf16_t*)(dob + DO_KA), *VAT = (const bf16_t*)(dob + DO_VAT);
    bf16_t* Y = (bf16_t*)(p.ws + OFF_HN);
    const int tida = opaque_tid();
    const int lane = tida & 63, w = tida >> 6, l15 = lane & 15, quad = lane >> 4;
    const float* lf = p.a_lambda + layer * 128;
    float sa = 0.f, sb = 0.f;
    if (lane < 32) { sa = lf[lane] * lf[32 + lane]; sb = lf[64 + lane] * lf[96 + lane]; }
    sa = wave_sum(sa); sb = wave_sum(sb);
    const float lam = __expf(sa) - __expf(sb) + lam_init;
    const float mq = wave_max(fabsf(p.a_qnorm[layer * 32 + (lane & 31)])), mk = wave_max(fabsf(p.a_knorm[layer * 32 + (lane & 31)]));
    const float scale = 0.17677669529663687f;
    const float c1 = scale * LOG2E, c2 = 32.f * mq * mk * scale * LOG2E;
    const int qt0 = qt_first + w * 32;
    const size_t ho = (size_t)((b * 4 + h) * 2) * TB * 32, mo = (size_t)TB * 32;
    f32x4 acc[2][2][4]; float ls[2][2];
    bf16x8 qf[2][2];
#pragma unroll
    for (int m = 0; m < 2; ++m)
#pragma unroll
        for (int qt = 0; qt < 2; ++qt) {
            ls[m][qt] = 0.f;
            qf[m][qt] = ld8(QA + ho + m * mo + (size_t)(qt0 + qt * 16 + l15) * 32 + quad * 8);
#pragma unroll
            for (int dt = 0; dt < 4; ++dt) acc[m][qt][dt] = (f32x4){0.f, 0.f, 0.f, 0.f};
        }
    const int gsw = (tida >> 4) & 3, gws = (gsw == 0) ? 0 : (gsw == 1) ? 2 : (gsw == 2) ? 3 : 1;
    const int srow = (tida >> 2) & 63, sch = tida & 3;
    const bf16_t* kg = KA + ho + (size_t)(tida >> 7) * mo + (size_t)((tida >> 2) & 31) * 32 + sch * 8;
    const bf16_t* vg = VAT + (size_t)(b * 4 + h) * 64 * TB + (size_t)srow * 32 + sch * 8;
    const int kw = (tida >> 7) * 2048 + ((tida >> 2) & 31) * 64 + ((sch ^ gws) << 4);
    const int vw = 4096 + srow * 64 + ((sch ^ gws) << 4);
    const int gsr = (l15 >> 2) & 3, grs = (gsr == 0) ? 0 : (gsr == 1) ? 2 : (gsr == 2) ? 3 : 1;
    const int fo = l15 * 64 + ((quad ^ grs) << 4);
    u32x4 rk = *(const u32x4*)kg, rv = *(const u32x4*)vg;
    *(u32x4*)(lds + kw) = rk; *(u32x4*)(lds + vw) = rv;
    __syncthreads();
#pragma unroll 1
    for (int kb = 0; kb < kend; kb += 32) {
        char* cur = lds + ((kb >> 5) & 1) * 8192;
        char* nxt = lds + (((kb >> 5) + 1) & 1) * 8192;
        const bool more = kb + 32 < kend;
        if (more) { rk = *(const u32x4*)(kg + (size_t)(kb + 32) * 32); rv = *(const u32x4*)(vg + (size_t)((kb + 32) >> 5) * 2048); }
        bf16x8 kf[2][2], vf[4];
#pragma unroll
        for (int m = 0; m < 2; ++m)
#pragma unroll
            for (int kt = 0; kt < 2; ++kt) kf[m][kt] = *(const bf16x8*)(cur + m * 2048 + kt * 1024 + fo);
#pragma unroll
        for (int dt = 0; dt < 4; ++dt) vf[dt] = *(const bf16x8*)(cur + 4096 + dt * 1024 + fo);
#pragma unroll
        for (int m = 0; m < 2; ++m)
#pragma unroll
            for (int qt = 0; qt < 2; ++qt) {
                f32x4 s[2];
#pragma unroll
                for (int kt = 0; kt < 2; ++kt) s[kt] = mfma16(kf[m][kt], qf[m][qt], (f32x4){0.f, 0.f, 0.f, 0.f});
                float ps = 0.f;
#pragma unroll
                for (int kt = 0; kt < 2; ++kt)
#pragma unroll
                    for (int j = 0; j < 4; ++j) { const float pv = __builtin_amdgcn_exp2f(s[kt][j] * c1 - c2); s[kt][j] = pv; ps += pv; }
                ls[m][qt] += ps;
                const bf16x8 pf = pack8(s[0], s[1]);
#pragma unroll
                for (int dt = 0; dt < 4; ++dt) acc[m][qt][dt] = mfma16(vf[dt], pf, acc[m][qt][dt]);
            }
        if (more) { *(u32x4*)(nxt + kw) = rk; *(u32x4*)(nxt + vw) = rv; }
        __syncthreads();
    }
    const float* sub = p.a_subln + layer * 64;
#pragma unroll
    for (int qt = 0; qt < 2; ++qt) {
        float l0 = ls[0][qt], l1 = ls[1][qt];
        l0 += __shfl_xor(l0, 16); l0 += __shfl_xor(l0, 32); l1 += __shfl_xor(l1, 16); l1 += __shfl_xor(l1, 32);
        const float i0 = 1.f / l0, i1 = lam / l1;
        f32x4 o[4]; float ss = 0.f;
#pragma unroll
        for (int dt = 0; dt < 4; ++dt) { o[dt] = acc[0][qt][dt] * i0 - acc[1][qt][dt] * i1; ss += o[dt][0] * o[dt][0] + o[dt][1] * o[dt][1] + o[dt][2] * o[dt][2] + o[dt][3] * o[dt][3]; }
        ss += __shfl_xor(ss, 16); ss += __shfl_xor(ss, 32);
        const float r = rsqrtf(ss * (1.f / 64.f) + EPS) * (1.f - lam_init);
        const size_t row = (size_t)b * TB + qt0 + qt * 16 + l15;
#pragma unroll
        for (int dt = 0; dt < 4; ++dt) {
            const int dv = dt * 16 + quad * 4;
            const f32x4 sw = *(const f32x4*)(sub + dv);
            u32x2 ov; ov.x = cvt_pk_bf16(o[dt][0] * r * sw[0], o[dt][1] * r * sw[1]); ov.y = cvt_pk_bf16(o[dt][2] * r * sw[2], o[dt][3] * r * sw[3]);
            *(u32x2*)(Y + row * D + h * 64 + dv) = ov;
        }
    }
}

__device__ __forceinline__ void attnB_item(const Params& p, int layer, int b, int hq, int qt_first, bool lat, char* lds) {
    char* dob = (char*)p.out;
    const bf16_t *QB = (const bf16_t*)(dob + DO_QB), *KB = (const bf16_t*)(dob + DO_KB), *VBT = (const bf16_t*)(dob + DO_VBT);
    bf16_t* Y = (bf16_t*)(p.ws + OFF_HN);
    const int tidb = opaque_tid();
    const int lane = tidb & 63, w = tidb >> 6, l15 = lane & 15, quad = lane >> 4, kvh = hq / 3;
    const float mq = wave_max(fabsf(p.b_qnorm[layer * 64 + lane])), mk = wave_max(fabsf(p.b_knorm[layer * 64 + lane]));
    const float scale = 0.125f, c1 = scale * LOG2E, c2 = 64.f * mq * mk * scale * LOG2E;
    const int qt0 = qt_first + w * 32;
    f32x4 acc[2][4]; float ls[2] = {0.f, 0.f};
#pragma unroll
    for (int qt = 0; qt < 2; ++qt)
#pragma unroll
        for (int dt = 0; dt < 4; ++dt) acc[qt][dt] = (f32x4){0.f, 0.f, 0.f, 0.f};
    const bf16_t* Qp = QB + (size_t)(b * 6 + hq) * TB * 64;
    const bf16_t* Kp = KB + (size_t)(b * 2 + kvh) * TB * 64;
    const bf16_t* Vp = VBT + (size_t)(b * 2 + kvh) * 64 * TB;
    int lo = 0, nst = 8;
    if (lat) {
        lo = qt_first - 128; if (lo < TC) lo = TC;
        int hi = qt_first + 128 + 128; if (hi > TB) hi = TB;
        lo &= ~31; hi = (hi + 31) & ~31;
        nst += (hi - lo) >> 5;
    }
    bf16x8 qf[2][2];
#pragma unroll
    for (int qt = 0; qt < 2; ++qt)
#pragma unroll
        for (int ks = 0; ks < 2; ++ks) qf[qt][ks] = ld8(Qp + (size_t)(qt0 + qt * 16 + l15) * 64 + ks * 32 + quad * 8);
    const int skey = tidb >> 3, skc = tidb & 7;
    const int sdv = tidb >> 2, svc = tidb & 3;
    const int gsw = (tidb >> 4) & 3, gws = (gsw == 0) ? 0 : (gsw == 1) ? 2 : (gsw == 2) ? 3 : 1;
    const bf16_t* kg = Kp + (size_t)skey * 64 + skc * 8;
    const bf16_t* vg = Vp + (size_t)sdv * 32 + svc * 8;
    const int kw = skey * 128 + ((skc ^ ((skey >> 1) & 7)) << 4);
    const int vw = 4096 + sdv * 64 + ((svc ^ gws) << 4);
    const int gsr = (l15 >> 2) & 3, grs = (gsr == 0) ? 0 : (gsr == 1) ? 2 : (gsr == 2) ? 3 : 1;
    const int kfo = l15 * 128;
    const int vfo = 4096 + l15 * 64 + ((quad ^ grs) << 4);
    u32x4 rk = *(const u32x4*)kg, rv = *(const u32x4*)vg;
    *(u32x4*)(lds + kw) = rk; *(u32x4*)(lds + vw) = rv;
    __syncthreads();
#pragma unroll 1
    for (int st = 0; st < nst; ++st) {
        const int kb = (st < 8) ? st * 32 : lo + (st - 8) * 32;
        const bool band = st >= 8;
        char* cur = lds + (st & 1) * 8192;
        char* nxt = lds + ((st + 1) & 1) * 8192;
        const bool more = st + 1 < nst;
        if (more) { const int kn = (st + 1 < 8) ? (st + 1) * 32 : lo + (st + 1 - 8) * 32; rk = *(const u32x4*)(kg + (size_t)kn * 64); rv = *(const u32x4*)(vg + (size_t)(kn >> 5) * 2048); }
        bf16x8 kf[2][2], vf[4];
#pragma unroll
        for (int kt = 0; kt < 2; ++kt)
#pragma unroll
            for (int ks = 0; ks < 2; ++ks) kf[kt][ks] = *(const bf16x8*)(cur + kt * 2048 + kfo + (((ks * 4 + quad) ^ (l15 >> 1)) << 4));
#pragma unroll
        for (int dt = 0; dt < 4; ++dt) vf[dt] = *(const bf16x8*)(cur + vfo + dt * 1024);
#pragma unroll
        for (int qt = 0; qt < 2; ++qt) {
            f32x4 s[2];
#pragma unroll
            for (int kt = 0; kt < 2; ++kt) {
                s[kt] = (f32x4){0.f, 0.f, 0.f, 0.f};
#pragma unroll
                for (int ks = 0; ks < 2; ++ks) s[kt] = mfma16(kf[kt][ks], qf[qt][ks], s[kt]);
            }
            float ps = 0.f;
#pragma unroll
            for (int kt = 0; kt < 2; ++kt)
#pragma unroll
                for (int j = 0; j < 4; ++j) {
                    float pv = __builtin_amdgcn_exp2f(s[kt][j] * c1 - c2);
                    if (band) {
                        const int dd = (qt0 + qt * 16 + l15) - (kb + kt * 16 + quad * 4 + j);
                        if (dd > 128 || dd < -128) pv = 0.f;
                    }
                    s[kt][j] = pv; ps += pv;
                }
            ls[qt] += ps;
            const bf16x8 pf = pack8(s[0], s[1]);
#pragma unroll
            for (int dt = 0; dt < 4; ++dt) acc[qt][dt] = mfma16(vf[dt], pf, acc[qt][dt]);
        }
        if (more) { *(u32x4*)(nxt + kw) = rk; *(u32x4*)(nxt + vw) = rv; }
        __syncthreads();
    }
    const float snk = exp2f(p.b_sink[layer * 6 + hq] * LOG2E - c2);
#pragma unroll
    for (int qt = 0; qt < 2; ++qt) {
        float l0 = ls[qt]; l0 += __shfl_xor(l0, 16); l0 += __shfl_xor(l0, 32);
        const float inv = 1.f / (l0 + snk);
        const size_t row = (size_t)b * TB + qt0 + qt * 16 + l15;
#pragma unroll
        for (int dt = 0; dt < 4; ++dt) {
            const int dv = dt * 16 + quad * 4;
            u32x2 ov; ov.x = cvt_pk_bf16(acc[qt][dt][0] * inv, acc[qt][dt][1] * inv); ov.y = cvt_pk_bf16(acc[qt][dt][2] * inv, acc[qt][dt][3] * inv);
            *(u32x2*)(Y + row * D + 256 + hq * 64 + dv) = ov;
        }
    }
}

__device__ __forceinline__ void chunk_prep(const Params& p, int b, int c, int h, char* lds) {
    float* As = (float*)lds;
    float* Gs = As + 2 * 64 * 68;
    float* Bs = Gs + 128;
    bf16_t* KS = (bf16_t*)(lds + 35840);
    bf16_t* VS = KS + 4096;
    const bf16_t *QC = (const bf16_t*)(p.ws + OFF_QC), *KC = (const bf16_t*)(p.ws + OFF_KC), *VC = (const bf16_t*)(p.ws + OFF_VC);
    const float *G = (const float*)(p.ws + OFF_G), *BETA = (const float*)(p.ws + OFF_BETA);
    bf16_t* REC = (bf16_t*)(p.ws + OFF_BIG);
    float *EG = (float*)(p.ws + OFF_EG), *GL = (float*)(p.ws + OFF_GL);
    const int tid = opaque_tid(), lane = tid & 63, w = tid >> 6, l15 = lane & 15, quad = lane >> 4;
    const size_t row0 = (size_t)b * TB + c * 64;
    const size_t rec0 = ((size_t)(b * 36 + c) * 6 + h) * 2;
    {
        const int r = tid >> 3, ch = tid & 7;
        const u32x4 k0 = *(const u32x4*)(KC + (row0 + r) * 384 + h * 64 + ch * 8), k1 = *(const u32x4*)(KC + (row0 + r + 32) * 384 + h * 64 + ch * 8);
        const u32x4 v0 = *(const u32x4*)(VC + (row0 + r) * 384 + h * 64 + ch * 8), v1 = *(const u32x4*)(VC + (row0 + r + 32) * 384 + h * 64 + ch * 8);
        *(u32x4*)(KS + r * 64 + ch * 8) = k0; *(u32x4*)(KS + (r + 32) * 64 + ch * 8) = k1;
        *(u32x4*)(VS + r * 64 + ch * 8) = v0; *(u32x4*)(VS + (r + 32) * 64 + ch * 8) = v1;
    }
    if (w < 2) {
        const int d = w, tok = d ? 63 - lane : lane;
        float g = G[(row0 + tok) * 12 + d * 6 + h];
#pragma unroll
        for (int off = 1; off < 64; off <<= 1) { const float n = __shfl_up(g, off); if (lane >= off) g += n; }
        Gs[d * 64 + lane] = g; Bs[d * 64 + lane] = BETA[(row0 + tok) * 12 + d * 6 + h];
    }
    f32x4 kk[4], qk[4];
    {
        bf16x8 kj[4][2], ki[2], qi[2];
#pragma unroll
        for (int jt = 0; jt < 4; ++jt)
#pragma unroll
            for (int ks = 0; ks < 2; ++ks) kj[jt][ks] = ld8(KC + (row0 + jt * 16 + l15) * 384 + h * 64 + ks * 32 + quad * 8);
#pragma unroll
        for (int ks = 0; ks < 2; ++ks) { ki[ks] = ld8(KC + (row0 + w * 16 + l15) * 384 + h * 64 + ks * 32 + quad * 8); qi[ks] = ld8(QC + (row0 + w * 16 + l15) * 384 + h * 64 + ks * 32 + quad * 8); }
#pragma unroll
        for (int jt = 0; jt < 4; ++jt) {
            kk[jt] = (f32x4){0.f, 0.f, 0.f, 0.f}; qk[jt] = (f32x4){0.f, 0.f, 0.f, 0.f};
#pragma unroll
            for (int ks = 0; ks < 2; ++ks) { kk[jt] = mfma16(ki[ks], kj[jt][ks], kk[jt]); qk[jt] = mfma16(qi[ks], kj[jt][ks], qk[jt]); }
        }
    }
    __syncthreads();
    {
        bf16_t* R0 = REC + rec0 * 16384 + 8192;
        bf16_t* R1 = REC + (rec0 + 1) * 16384 + 8192;
#pragma unroll
        for (int jt = 0; jt < 4; ++jt)
#pragma unroll
            for (int r = 0; r < 4; ++r) {
                const int i = w * 16 + quad * 4 + r, j = jt * 16 + l15;
                const float kv = kk[jt][r], qv = qk[jt][r];
                {
                    const float dec = (i >= j) ? __expf(Gs[i] - Gs[j]) : 0.f;
                    if (i > j) As[i * 68 + j] = Bs[i] * kv * dec;
                    R0[i * 64 + kpos(j)] = f2bf(qv * dec);
                }
                {
                    const int ip = 63 - i, jp = 63 - j;
                    const float dec = (ip >= jp) ? __expf(Gs[64 + ip] - Gs[64 + jp]) : 0.f;
                    if (ip > jp) As[64 * 68 + ip * 68 + jp] = Bs[64 + ip] * kv * dec;
                    R1[ip * 64 + kpos(jp)] = f2bf(qv * dec);
                }
            }
    }
    __syncthreads();
    {
        const int d = tid >> 7, cc = tid & 127;
        const float* Ad = As + d * 64 * 68;
        const float* Gd = Gs + d * 64;
        const float* Bd = Bs + d * 64;
        float x[64];
        const bool isw = cc >= 64;
        const bf16_t* srcp = isw ? KS + kpos(cc - 64) : VS + cc;
#pragma unroll
        for (int g = 0; g < 4; ++g) {
#pragma unroll
            for (int q = 0; q < 16; ++q) {
                const int ip = g * 16 + q, tok = d ? 63 - ip : ip;
                x[ip] = Bd[ip] * (isw ? __expf(Gd[ip]) : 1.f) * bf2f(srcp[tok * 64]);
            }
            asm volatile("" ::: "memory");
        }
#pragma unroll
        for (int ip = 1; ip < 64; ++ip) {
            float s4[4] = {x[ip], 0.f, 0.f, 0.f};
#pragma unroll
            for (int j4 = 0; j4 < (ip + 3) / 4; ++j4) {
                const f32x4 a = *(const f32x4*)(Ad + ip * 68 + j4 * 4);
#pragma unroll
                for (int q = 0; q < 4; ++q) if (j4 * 4 + q < ip) s4[q] -= a[q] * x[j4 * 4 + q];
            }
            x[ip] = (s4[0] + s4[1]) + (s4[2] + s4[3]);
            if ((ip & 3) == 3) asm volatile("" ::: "memory");
        }
        bf16_t* R = REC + (rec0 + d) * 16384;
        if (cc < 64) {
#pragma unroll
            for (int i8 = 0; i8 < 8; ++i8) {
                u32x4 o; o.x = cvt_pk_bf16(x[i8 * 8], x[i8 * 8 + 1]); o.y = cvt_pk_bf16(x[i8 * 8 + 2], x[i8 * 8 + 3]); o.z = cvt_pk_bf16(x[i8 * 8 + 4], x[i8 * 8 + 5]); o.w = cvt_pk_bf16(x[i8 * 8 + 6], x[i8 * 8 + 7]);
                *(u32x4*)(R + cc * 64 + i8 * 8) = o;
            }
            const float gl = Gd[63];
            const bf16_t* kcol = KS + kpos(cc);
#pragma unroll 2
            for (int i8 = 0; i8 < 8; ++i8) {
                float kv[8];
#pragma unroll
                for (int q = 0; q < 8; ++q) { const int ip = (i8 >> 2) * 32 + (q >> 2) * 16 + (i8 & 3) * 4 + (q & 3), tok = d ? 63 - ip : ip; kv[q] = bf2f(kcol[tok * 64]) * __expf(gl - Gd[ip]); }
                u32x4 o; o.x = cvt_pk_bf16(kv[0], kv[1]); o.y = cvt_pk_bf16(kv[2], kv[3]); o.z = cvt_pk_bf16(kv[4], kv[5]); o.w = cvt_pk_bf16(kv[6], kv[7]);
                *(u32x4*)(R + 12288 + cc * 64 + i8 * 8) = o;
            }
        } else {
            { const int wp = kpos(cc - 64);
#pragma unroll
            for (int ip = 0; ip < 64; ++ip) R[4096 + ip * 64 + wp] = f2bf(-x[ip]); }
            const int ip = cc - 64; const float eg = __expf(Gd[ip]);
            EG[(rec0 + d) * 64 + ip] = eg;
            if (ip == 63) GL[rec0 + d] = eg;
        }
    }
    __syncthreads();
}

__device__ __forceinline__ void scan_chain(const Params& p, int b, int h, int d, bool need_ctx) {
    const bf16_t* REC = (const bf16_t*)(p.ws + OFF_BIG);
    const bf16_t* QC = (const bf16_t*)(p.ws + OFF_QC);
    const float *EG = (const float*)(p.ws + OFF_EG), *GL = (const float*)(p.ws + OFF_GL);
    bf16_t* O = (bf16_t*)(p.ws + (d ? OFF_VC : OFF_KC));
    const int tids = opaque_tid();
    const int lane = tids & 63, w = tids >> 6, l15 = lane & 15, quad = lane >> 4;
    f32x4 S[4];
#pragma unroll
    for (int kt = 0; kt < 4; ++kt) S[kt] = (f32x4){0.f, 0.f, 0.f, 0.f};
    for (int step = 0; step < 36; ++step) {
        const int c = d ? (step < 4 ? 3 - step : 39 - step) : step;
        const size_t rec = ((size_t)(b * 36 + c) * 6 + h) * 2 + d;
        const bf16_t* R = REC + rec * 16384;
        const size_t row0 = (size_t)b * TB + c * 64;
        const bf16_t* Rl = R + l15 * 64 + quad * 8;
        bf16x8 wf[4][2], qkf[4][2], kdf[4][2];
        u32x4 qraw[4][2]; float egv[4]; u32x2 uraw[4];
#pragma unroll
        for (int lt = 0; lt < 4; ++lt) {
            uraw[lt] = *(const u32x2*)(R + (16 * w + l15) * 64 + lt * 16 + quad * 4);
#pragma unroll
            for (int ks = 0; ks < 2; ++ks) wf[lt][ks] = ld8(Rl + 4096 + lt * 1024 + ks * 32);
        }
#pragma unroll
        for (int lt = 0; lt < 4; ++lt) {
            const int Lr = lt * 16 + l15, tok = d ? 63 - Lr : Lr;
            egv[lt] = EG[rec * 64 + Lr];
            const bf16_t* qrow = QC + (row0 + tok) * 384 + h * 64 + quad * 8;
#pragma unroll
            for (int ks = 0; ks < 2; ++ks) qraw[lt][ks] = *(const u32x4*)(qrow + ks * 32);
#pragma unroll
            for (int ls = 0; ls < 2; ++ls) qkf[lt][ls] = ld8(Rl + 8192 + lt * 1024 + ls * 32);
        }
#pragma unroll
        for (int kt = 0; kt < 4; ++kt)
#pragma unroll
            for (int ls = 0; ls < 2; ++ls) kdf[kt][ls] = ld8(Rl + 12288 + kt * 1024 + ls * 32);
        const float gl = GL[rec];
        asm volatile("" ::: "memory");
        bf16x8 Sb[2], Vb[2];
        Sb[0] = pack8(S[0], S[1]); Sb[1] = pack8(S[2], S[3]);
        f32x4 vn[4];
#pragma unroll
        for (int lt = 0; lt < 4; ++lt) {
            vn[lt] = (f32x4){bflo(uraw[lt].x), bfhi(uraw[lt].x), bflo(uraw[lt].y), bfhi(uraw[lt].y)};
#pragma unroll
            for (int ks = 0; ks < 2; ++ks) vn[lt] = mfma16(wf[lt][ks], Sb[ks], vn[lt]);
        }
        Vb[0] = pack8(vn[0], vn[1]); Vb[1] = pack8(vn[2], vn[3]);
        f32x4 o[4];
#pragma unroll
        for (int lt = 0; lt < 4; ++lt) {
            const float eg = egv[lt];
            o[lt] = (f32x4){0.f, 0.f, 0.f, 0.f};
#pragma unroll
            for (int ks = 0; ks < 2; ++ks) {
                const u32x4 qa = qraw[lt][ks];
                u32x4 qq; qq.x = cvt_pk_bf16(bflo(qa.x) * eg, bfhi(qa.x) * eg); qq.y = cvt_pk_bf16(bflo(qa.y) * eg, bfhi(qa.y) * eg);
                qq.z = cvt_pk_bf16(bflo(qa.z) * eg, bfhi(qa.z) * eg); qq.w = cvt_pk_bf16(bflo(qa.w) * eg, bfhi(qa.w) * eg);
                o[lt] = mfma16(__builtin_bit_cast(bf16x8, qq), Sb[ks], o[lt]);
            }
#pragma unroll
            for (int ls = 0; ls < 2; ++ls) o[lt] = mfma16(qkf[lt][ls], Vb[ls], o[lt]);
        }
#pragma unroll
        for (int kt = 0; kt < 4; ++kt) {
            S[kt] = S[kt] * gl;
#pragma unroll
            for (int ls = 0; ls < 2; ++ls) S[kt] = mfma16(kdf[kt][ls], Vb[ls], S[kt]);
        }
        if (need_ctx || c >= 4) {
#pragma unroll
            for (int lt = 0; lt < 4; ++lt)
#pragma unroll
                for (int r = 0; r < 4; ++r) { const int L = lt * 16 + quad * 4 + r, tok = d ? 63 - L : L; O[(row0 + tok) * 384 + h * 64 + 16 * w + l15] = f2bf(o[lt][r]); }
        }
    }
}

__device__ __forceinline__ void cout_phase(const Params& p, int layer, bool need_ctx) {
    const bf16_t *O0 = (const bf16_t*)(p.ws + OFF_KC), *O1 = (const bf16_t*)(p.ws + OFF_VC);
    bf16_t* Y = (bf16_t*)(p.ws + OFF_HN);
    const int tidc = opaque_tid();
    const int lane = tidc & 63, gw = blockIdx.x * 4 + (tidc >> 6), nw = gridDim.x * 4;
    const float wn = p.c_onorm[layer * 64 + lane];
    for (int rb = gw * 9; rb < M; rb += nw * 9) {
#pragma unroll 1
        for (int g3 = 0; g3 < 3; ++g3) {
            unsigned short o0[3][6], o1[3][6], gzr[3][6]; bool ok[3];
#pragma unroll
            for (int u = 0; u < 3; ++u) {
                const int row = rb + g3 * 3 + u;
                const int t = row % TB;
                ok[u] = (row < M) && (need_ctx || t >= TC);
                if (ok[u]) {
#pragma unroll
                    for (int hh = 0; hh < 6; ++hh) {
                        const size_t oi = (size_t)row * 384 + hh * 64 + lane;
                        o0[u][hh] = O0[oi]; o1[u][hh] = O1[oi]; gzr[u][hh] = Y[(size_t)row * D + 640 + hh * 64 + lane];
                    }
                }
            }
            asm volatile("" ::: "memory");
#pragma unroll
            for (int u = 0; u < 3; ++u) {
                if (!ok[u]) continue;
                const int row = rb + g3 * 3 + u;
#pragma unroll
                for (int hh = 0; hh < 6; ++hh) {
                    const float o = bf2f(o0[u][hh]) + bf2f(o1[u][hh]);
                    const float ss = wave_sum(o * o);
                    Y[(size_t)row * D + 640 + hh * 64 + lane] = f2bf(o * rsqrtf(ss * (1.f / 64.f) + EPS) * wn * bf2f(gzr[u][hh]));
                }
            }
        }
    }
}


#define DBG_NAN 0
__device__ __forceinline__ void dbg_scan(const void* ptr, size_t nbytes, bool is_bf16, unsigned* flag, unsigned code) {
    const u32x4* q = (const u32x4*)ptr; const size_t n = nbytes / 16;
    bool bad = false;
    for (size_t i = (size_t)blockIdx.x * 256 + threadIdx.x; i < n; i += (size_t)gridDim.x * 256) {
        const u32x4 v = q[i];
#pragma unroll
        for (int k = 0; k < 4; ++k) {
            const unsigned u = v[k];
            if (is_bf16) { if ((u & 0x7F80u) > (140u << 7) || (u & 0x7F800000u) > (140u << 23)) bad = true; }
            else if ((u & 0x7F800000u) > (140u << 23)) bad = true;
        }
    }
    if (bad) atomicMin(flag, code);
}

#define XB_TMO      128
#define XB_XCNT(j)  (256  + 64 * (j))
#define XB_XSUB(j)  (1280 + 64 * (j))
#define XB_XGEN(j)  (2304 + 64 * (j))
#define XB_TOP      3328
#define XB_TOPGEN   3392
#define XB_SPIN_CAP (1u << 21)
#define LAS __attribute__((address_space(3)))
__device__ __forceinline__ unsigned xb_ld(unsigned* p)              { return __hip_atomic_load(p, __ATOMIC_RELAXED, __HIP_MEMORY_SCOPE_AGENT); }
__device__ __forceinline__ unsigned xb_add(unsigned* p, unsigned v) { return __hip_atomic_fetch_add(p, v, __ATOMIC_RELAXED, __HIP_MEMORY_SCOPE_AGENT); }
__device__ __forceinline__ unsigned xb_xcc_id() { return (unsigned)__builtin_amdgcn_s_getreg((3 << 11) | 20) & 0xFu; }
#define XB_SPIN(cond, bar) do { unsigned _sp = 0; while (cond) { __builtin_amdgcn_s_sleep(1); \
    if ((++_sp & 255u) == 0u) { if (xb_ld(&(bar)[XB_TMO])) break; if (_sp > XB_SPIN_CAP) { atomicAdd(&(bar)[XB_TMO], 1u); break; } } } } while (0)
__device__ __forceinline__ void xcd_barrier_complete(unsigned* bar, unsigned x, unsigned& nloc, unsigned& nx) {
    const unsigned G = gridDim.x * gridDim.y * gridDim.z;
    unsigned sum, cnt, mine, sp = 0u;
    for (;;) {
        sum = 0u; cnt = 0u; mine = 0u;
#pragma unroll
        for (unsigned j = 0; j < 16; ++j) { const unsigned c = xb_ld(&bar[XB_XCNT(j)]); sum += c; cnt += (c > 0u) ? 1u : 0u; mine = (j == x) ? c : mine; }
        if (sum == G) break;
        __builtin_amdgcn_s_sleep(1);
        if ((++sp & 255u) == 0u) { if (xb_ld(&bar[XB_TMO])) break; if (sp > XB_SPIN_CAP) { atomicAdd(&bar[XB_TMO], 1u); break; } }
    }
    nloc = mine > 0u ? mine : 1u; nx = cnt > 0u ? cnt : 1u;
}
__device__ __forceinline__ void xcd_barrier(unsigned* bar, volatile LAS unsigned* st) {
    asm volatile("s_waitcnt vmcnt(0)" ::: "memory");
    __syncthreads();
    if (threadIdx.x == 0) {
        const unsigned x = xb_xcc_id();
        __builtin_amdgcn_s_waitcnt(0);
        unsigned nloc = st[0], nx = st[1];
        if (nloc == 0u) { xcd_barrier_complete(bar, x, nloc, nx); st[0] = nloc; st[1] = nx; }
        const unsigned old = xb_add(&bar[XB_XSUB(x)], 1u);
        const unsigned gen = old / nloc;
        if (old + 1u == (gen + 1u) * nloc) {
            __builtin_amdgcn_fence(__ATOMIC_RELEASE, "agent");
            asm volatile("s_waitcnt vmcnt(0)" ::: "memory");
            const unsigned og = xb_add(&bar[XB_TOP], 1u);
            const unsigned tg = og / nx;
            if (og + 1u == (tg + 1u) * nx) xb_add(&bar[XB_TOPGEN], 1u);
            else XB_SPIN(xb_ld(&bar[XB_TOPGEN]) == tg, bar);
            __builtin_amdgcn_fence(__ATOMIC_ACQUIRE, "agent");
            xb_add(&bar[XB_XGEN(x)], 1u);
            asm volatile("s_waitcnt vmcnt(0)" ::: "memory");
        } else {
            XB_SPIN(xb_ld(&bar[XB_XGEN(x)]) == gen, bar);
            __builtin_amdgcn_fence(__ATOMIC_ACQUIRE, "agent");
            asm volatile("s_waitcnt vmcnt(0)" ::: "memory");
        }
    }
    __syncthreads();
}

__device__ __forceinline__ void conv_jobs(const Params& p, int set, int first, int stride, char* lds) {
    bf16_t* Wb = (bf16_t*)(p.ws + OFF_W);
    const int j0 = (set == 2) ? 3 : 0, j1 = (set == 1) ? 3 : 6;
    const size_t lo = (set == 0) ? 0 : 1;
    for (int j = j0; j < j1; ++j) {
        const float* W; bf16_t* Wt; int K, N, Npad, mode;
        switch (j) {
            case 0: W = p.ffn1_w1 + lo * 1024 * 5632; Wt = Wb + WO_W1A; K = 1024; N = 5632; Npad = 5632; mode = 1; break;
            case 1: W = p.ffn1_w2 + lo * 2816 * 1024; Wt = Wb + WO_W2A; K = 2816; N = 1024; Npad = 1024; mode = 0; break;
            case 2: W = p.w_in + lo * 1024 * NIN; Wt = Wb + WO_WIN; K = 1024; N = NIN; Npad = NINP; mode = 0; break;
            case 3: W = p.w_out + lo * 1024 * 1024; Wt = Wb + WO_WOUT; K = 1024; N = 1024; Npad = 1024; mode = 0; break;
            case 4: W = p.ffn2_w1 + lo * 1024 * 5632; Wt = Wb + WO_W1B; K = 1024; N = 5632; Npad = 5632; mode = 1; break;
            default: W = p.ffn2_w2 + lo * 2816 * 1024; Wt = Wb + WO_W2B; K = 2816; N = 1024; Npad = 1024; mode = 0; break;
        }
        const int nt = (K >> 6) * (Npad >> 7);
#pragma unroll 1
        for (int t = first; t < nt; t += stride) convert_tile(W, K, N, Wt, mode, t, lds);
    }
}

__global__ void __launch_bounds__(256, 2) fwd_megakernel(Params p) {
    cg::grid_group grid = cg::this_grid();
    __shared__ __attribute__((aligned(16))) char lds[65536];
    volatile int& s_item = *(volatile int*)(lds + 65024);
    __shared__ uint4 xb_words;
    if (threadIdx.x == 0) { xb_words = make_uint4(0u, 0u, 0u, 0u); (void)xb_add((unsigned*)(p.ws + OFF_BAR) + XB_XCNT(xb_xcc_id()), 1u); }
    __syncthreads();

#pragma unroll 1
    for (int st = -1; st < 26; ++st) {
        const int layer = (st < 13) ? 0 : 1, s = (st < 0) ? -1 : st - layer * 13;
        const bool last = layer == 1, need_ctx = !last;
        bf16_t* Wb = (bf16_t*)(p.ws + OFF_W);
        float* H = (float*)(p.ws + OFF_H);
        bf16_t* HN = (bf16_t*)(p.ws + OFF_HN);
        bf16_t* BIG = (bf16_t*)(p.ws + OFF_BIG);
        const float* modL = (const float*)(p.ws + OFF_MOD) + (size_t)layer * 9 * 9216;
        switch (s) {
        case -1: {
            unsigned* CTR = (unsigned*)(p.ws + OFF_CTR);
            const int tid = opaque_tid();
#pragma unroll 1
            for (int it = blockIdx.x; it < 288; it += gridDim.x) mod_tile(p, it, lds);
            conv_jobs(p, 0, blockIdx.x, gridDim.x, lds);
            for (size_t i = (size_t)blockIdx.x * 256 + tid; i < (size_t)M * 256; i += (size_t)gridDim.x * 256) {
                const int row = (int)(i >> 8), c4 = (int)(i & 255), b = row / TB, t = row - b * TB;
                const float* src = (t < TC) ? p.ctx + ((size_t)b * TC + t) * D : p.x + ((size_t)b * TL + (t - TC)) * D;
                *(f32x4*)(H + (size_t)row * D + c4 * 4) = *(const f32x4*)(src + c4 * 4);
            }
        } break;
        case 0: case 3: case 10:
            norm_phase(p, layer, s == 10 ? 6 : s, last && s == 10);
            break;
        case 1: case 11: {
            EpiArgs e{}; e.obf = BIG;
            gemm256_phase<0>(HN, Wb + (s == 1 ? WO_W1A : WO_W1B), 1024, 44, last && s == 11, e, lds);
        } break;
        case 2: case 9: case 12: {
            EpiArgs e{}; e.H = H; e.gate = modL + (s == 2 ? 2 : (s == 9 ? 5 : 8)) * 1024; e.gscale = (s == 9) ? 1.0f : 0.5f;
            e.outp = (last && s == 12) ? p.out : nullptr;
            gemm_phase<1>(s == 9 ? HN : BIG, Wb + (s == 2 ? WO_W2A : (s == 9 ? WO_WOUT : WO_W2B)), s == 9 ? 1024 : 2816, 8, last && s >= 9, e, lds);
        } break;
        case 4: {
            EpiArgs e{}; e.obf = BIG; e.ldo = NINP;
            gemm256_phase<2>(HN, Wb + WO_WIN, 1024, 24, false, e, lds);
        } break;
        case 5:
            prep_phase(p, layer, lds);
            break;
        case 6: {
            unsigned* CTR = (unsigned*)(p.ws + OFF_CTR);
#pragma unroll 1
            for (;;) {
                if (threadIdx.x == 0) s_item = (int)atomicAdd(&CTR[layer], 1u);
                __syncthreads();
                const int it = s_item;
                __syncthreads();
                if (it >= 1728) break;
                const int h = it % 6, c = (it / 6) % 36, b = it / 216;
                chunk_prep(p, b, c, h, lds);
            }
        } break;
        case 7:
            if (blockIdx.x < 96) { const int d = blockIdx.x & 1, h = (blockIdx.x >> 1) % 6, b = blockIdx.x / 12; __builtin_amdgcn_s_setprio(3); scan_chain(p, b, h, d, need_ctx); __builtin_amdgcn_s_setprio(0); }
            else {
                conv_jobs(p, last ? 2 : 1, blockIdx.x - 96, gridDim.x - 96, lds);
                unsigned* CTR = (unsigned*)(p.ws + OFF_CTR);
                const float lam_init = last ? 0.35550906759f : 0.2f;
                const int nq = 64 + (need_ctx ? 8 : 0);
                const unsigned x0 = xb_xcc_id() & 7u;
#pragma unroll 1
                for (int v = 0; v < 8; ++v) {
                    const int xq = (int)((x0 + v) & 7u);
#pragma unroll 1
                    for (;;) {
                        if (threadIdx.x == 0) s_item = (int)atomicAdd(&CTR[8 + layer * 8 + xq], 1u);
                        __syncthreads();
                        const int q = s_item;
                        __syncthreads();
                        if (q >= nq) break;
                        const bool lat = q < 64; const int j = lat ? q : q - 64;
                        const int bh = xq + 8 * (lat ? (j >> 4) : (j >> 1)), qb = lat ? (j & 15) : (j & 1);
                        attnA_item(p, layer, bh >> 2, bh & 3, lat ? TC + qb * 128 : qb * 128, lat ? TB : TC, lam_init, lds);
                    }
                }
                {
                    const int nBl = 768, e2 = nBl + (need_ctx ? 96 : 0);
#pragma unroll 1
                    for (;;) {
                        if (threadIdx.x == 0) s_item = (int)atomicAdd(&CTR[4 + layer], 1u);
                        __syncthreads();
                        const int it = s_item;
                        __syncthreads();
                        if (it >= e2) break;
                        const bool lat = it < nBl; const int j = lat ? it : it - nBl;
                        const int qb = lat ? (j & 15) : (j & 1), hq = lat ? ((j >> 4) % 6) : ((j >> 1) % 6), b = lat ? (j / 96) : (j / 12);
                        attnB_item(p, layer, b, hq, lat ? TC + qb * 128 : qb * 128, lat, lds);
                    }
                }
            }
            break;
        default:
            cout_phase(p, layer, need_ctx);
            break;
        }
        if (st == -1) grid.sync();
        else if (st != 25) xcd_barrier((unsigned*)(p.ws + OFF_BAR), (volatile LAS unsigned*)&xb_words);
#if DBG_NAN
        {
            unsigned* flag = (unsigned*)(p.ws + OFF_CTR) + 32;
            const unsigned code = (unsigned)(st + 2);
#pragma unroll 1
            for (int q = 0; q < 3; ++q) {
                const void* ptr = nullptr; size_t nb = 0; bool isb = true; unsigned cd = code;
                if (q == 0) {
                    if (s == -1) { ptr = p.ws + OFF_MOD; nb = (size_t)2 * 9 * 9216 * 4; isb = false; }
                    else if (s == 0 || s == 3 || s == 10 || s == 6 || s == 8) { ptr = HN; nb = SZ_HN; }
                    else if (s == 1 || s == 11) { ptr = BIG; nb = (size_t)M * DFF * 2; }
                    else if (s == 2 || s == 9 || (s == 12 && !last)) { ptr = H; nb = SZ_H; isb = false; }
                    else if (s == 4) { ptr = BIG; nb = SZ_BIG; }
                    else if (s == 5) { ptr = p.ws + OFF_QC; nb = 3 * SZ_QC; }
                    else if (s == 7) { ptr = p.out; nb = (size_t)2 * M * 384 * 4; isb = false; }
                } else if (q == 1) {
                    if (s == 5) { ptr = p.out; nb = DO_END; }
                    else if (s == 6) { ptr = BIG; nb = SZ_BIG; cd = code + 30; }
                } else {
                    if (s == 5) { ptr = p.ws + OFF_G; nb = (size_t)M * 24 * 4; isb = false; }
                    else if (s == 6) { ptr = p.ws + OFF_EG; nb = (size_t)NREC * 65 * 4; isb = false; cd = code + 60; }
                }
                if (nb) dbg_scan(ptr, nb, isb, flag, cd);
            }
            if (s == 4) {
                const unsigned idx = blockIdx.x * 256 + threadIdx.x;
                const unsigned row = (idx * 2654435761u) % (unsigned)M, col = (idx * 40503u) % (unsigned)NINP;
                const bf16_t* ar = HN + (size_t)row * D; const bf16_t* br = Wb + WO_WIN + (size_t)col * 1024;
                float dot = 0.f;
                for (int k = 0; k < 1024; ++k) dot += bf2f(ar[k]) * bf2f(br[k]);
                const float cv = bf2f(BIG[(size_t)row * NINP + col]);
                if (!(fabsf(dot - cv) <= 0.05f + 0.02f * fabsf(dot))) atomicMin(flag + 1, 77u);
                if (fabsf(dot) > 100.f) atomicMin(flag + 1, 66u);
            }
            if (s == -1) {
                bf16_t* Wq = (bf16_t*)(p.ws + OFF_W);
#pragma unroll 1
                for (int q = 0; q < 6; ++q) {
                    const size_t o = (q == 0) ? WO_W1A : (q == 1) ? WO_W2A : (q == 2) ? WO_WIN : (q == 3) ? WO_WOUT : (q == 4) ? WO_W1B : WO_W2B;
                    const size_t n = (q == 0 || q == 4) ? E_W1 : (q == 1 || q == 5) ? E_W2 : (q == 2) ? E_WIN : E_WOUT;
                    dbg_scan(Wq + o, n * 2, true, flag + 1, 91u + q);
                }
            }
            grid.sync();
        }
#endif
    }
#if DBG_NAN
    {
        const unsigned f = *((volatile unsigned*)(p.ws + OFF_CTR) + 32);
        const unsigned f2 = *((volatile unsigned*)(p.ws + OFF_CTR) + 33);
        const float codev = (f2 != 9999u) ? 100.f * (float)f2 : ((f == 9999u) ? 0.f : 100.f * (float)f);
        for (size_t i = (size_t)blockIdx.x * 256 + threadIdx.x; i < (size_t)NB * TL * D; i += (size_t)gridDim.x * 256) {
            float v = p.out[i];
            if ((__float_as_uint(v) & 0x7F800000u) == 0x7F800000u) v = 500.f;
            if (codev != 0.f) v = codev;
            p.out[i] = v;
        }
    }
#endif
}

extern "C" void kernel_launch(void* const* d_in, const int* in_sizes, int n_in, void* d_out, int out_size, void* d_ws, size_t ws_size, hipStream_t stream) {
    (void)in_sizes; (void)n_in; (void)out_size;
    static int grid_blocks = 0;
    if (!grid_blocks) {
        int dev = 0, cus = 0, per_cu = 0;
        (void)hipGetDevice(&dev);
        (void)hipDeviceGetAttribute(&cus, hipDeviceAttributeMultiprocessorCount, dev);
        (void)hipOccupancyMaxActiveBlocksPerMultiprocessor(&per_cu, fwd_megakernel, 256, 0);
        if (per_cu > 2) per_cu = 2;
        if (per_cu < 1) per_cu = 1;
        grid_blocks = cus * per_cu;
    }
    if (ws_size < WS_NEED) { fprintf(stderr, "workspace too small: %zu < %zu\n", ws_size, (size_t)WS_NEED); }
    Params p{};
    const float** f = (const float**)&p;
    for (int i = 0; i < 23; ++i) f[i] = (const float*)d_in[i];
    p.out = (float*)d_out; p.ws = (char*)d_ws;
    (void)hipMemsetAsync((char*)d_ws + OFF_CTR, 0, WS_NEED - OFF_CTR, stream);
    void* args[] = {&p};
    hipError_t e = hipLaunchCooperativeKernel((void*)fwd_megakernel, dim3(grid_blocks), dim3(256), args, 0, stream);
    if (e != hipSuccess) fprintf(stderr, "cooperative launch failed: %s (grid %d)\n", hipGetErrorString(e), grid_blocks);
}
```

```cpp
#include <hip/hip_runtime.h>
#include <hip/hip_cooperative_groups.h>
#include <cstdio>
#include <cstdint>
namespace cg = cooperative_groups;

typedef unsigned short bf16_t;
typedef short bf16x8 __attribute__((ext_vector_type(8)));
typedef short bf16x4 __attribute__((ext_vector_type(4)));
typedef float f32x4 __attribute__((ext_vector_type(4)));
typedef unsigned u32x2 __attribute__((ext_vector_type(2)));
typedef unsigned u32x4 __attribute__((ext_vector_type(4)));

constexpr int D = 1024, NB = 8, TL = 2048, TC = 256, TB = 2304, M = NB * TB;
constexpr int DFF = 2816, NIN = 2968, NINP = 3072;
constexpr int NREC = NB * 36 * 6 * 2;
constexpr float EPS = 1e-6f;
constexpr float LOG2E = 1.4426950408889634f;

constexpr size_t SZ_H = (size_t)M * D * 4;
constexpr size_t SZ_HN = (size_t)M * D * 2;
constexpr size_t SZ_BIG = (size_t)M * NINP * 2;
constexpr size_t E_W1 = (size_t)5632 * 1024, E_W2 = (size_t)1024 * 2816, E_WIN = (size_t)NINP * 1024, E_WOUT = (size_t)1024 * 1024;
constexpr size_t SZ_W = (2 * E_W1 + 2 * E_W2 + E_WIN + E_WOUT) * 2;
constexpr size_t SZ_QC = (size_t)M * 384 * 2;
constexpr size_t OFF_H = 0;
constexpr size_t OFF_HN = OFF_H + SZ_H;
constexpr size_t OFF_BIG = OFF_HN + SZ_HN;
constexpr size_t OFF_W = OFF_BIG + SZ_BIG;
constexpr size_t OFF_QC = OFF_W + SZ_W;
constexpr size_t OFF_KC = OFF_QC + SZ_QC;
constexpr size_t OFF_VC = OFF_KC + SZ_QC;
constexpr size_t OFF_MOD = OFF_VC + SZ_QC;
constexpr size_t OFF_G = OFF_MOD + (size_t)2 * 9 * 9216 * 4;
constexpr size_t OFF_BETA = OFF_G + (size_t)M * 12 * 4;
constexpr size_t OFF_EG = OFF_BETA + (size_t)M * 12 * 4;
constexpr size_t OFF_GL = OFF_EG + (size_t)NREC * 64 * 4;
constexpr size_t OFF_CTR = OFF_GL + (size_t)NREC * 4;
constexpr size_t OFF_BAR = OFF_CTR + 256;
constexpr size_t WS_NEED = OFF_BAR + 3456 * 4;
static_assert(SZ_BIG == (size_t)NREC * 32768, "record region");
constexpr size_t WO_W1A = 0, WO_W2A = WO_W1A + E_W1, WO_WIN = WO_W2A + E_W2, WO_WOUT = WO_WIN + E_WIN, WO_W1B = WO_WOUT + E_WOUT, WO_W2B = WO_W1B + E_W1;
constexpr size_t DO_QA = 0, DO_KA = DO_QA + (size_t)NB * 4 * 2 * TB * 32 * 2, DO_VAT = DO_KA + (size_t)NB * 4 * 2 * TB * 32 * 2,
                 DO_QB = DO_VAT + (size_t)NB * 4 * 64 * TB * 2, DO_KB = DO_QB + (size_t)NB * 6 * TB * 64 * 2, DO_VBT = DO_KB + (size_t)NB * 2 * TB * 64 * 2,
                 DO_END = DO_VBT + (size_t)NB * 2 * 64 * TB * 2;
static_assert(DO_END <= (size_t)NB * TL * D * 4, "d_out scratch");
static_assert((size_t)2 * M * 384 * 4 <= (size_t)NB * TL * D * 4, "O scratch");

struct Params {
    const float *x, *c, *ctx, *c_ctx, *w_mod, *b_mod, *ffn1_w1, *ffn1_w2, *ffn2_w1, *ffn2_w2, *w_in, *w_out;
    const float *a_qnorm, *a_knorm, *a_lambda, *a_subln, *b_qnorm, *b_knorm, *b_sink, *c_conv, *c_A_log, *c_dt_bias, *c_onorm;
    float* out;
    char* ws;
};

typedef __bf16 bf16v2_t __attribute__((ext_vector_type(2)));
typedef float f32x2_t __attribute__((ext_vector_type(2)));
__device__ __forceinline__ unsigned cvt_pk_bf16(float lo, float hi) { const f32x2_t v = {lo, hi}; const bf16v2_t r = __builtin_convertvector(v, bf16v2_t); return __builtin_bit_cast(unsigned, r); }
__device__ __forceinline__ bf16_t f2bf(float f) { return (bf16_t)(cvt_pk_bf16(f, 0.f) & 0xffffu); }
__device__ __forceinline__ float bf2f(bf16_t h) { return __uint_as_float(((unsigned)h) << 16); }
__device__ __forceinline__ float bflo(unsigned u) { return __uint_as_float(u << 16); }
__device__ __forceinline__ float bfhi(unsigned u) { return __uint_as_float(u & 0xffff0000u); }
__device__ __forceinline__ float siluf(float v) { return v / (1.f + __expf(-v)); }
__device__ __forceinline__ f32x4 mfma16(bf16x8 a, bf16x8 b, f32x4 c) { return __builtin_amdgcn_mfma_f32_16x16x32_bf16(a, b, c, 0, 0, 0); }
__device__ __forceinline__ bf16x8 pack8(f32x4 a, f32x4 b) {
    u32x4 r; r.x = cvt_pk_bf16(a[0], a[1]); r.y = cvt_pk_bf16(a[2], a[3]); r.z = cvt_pk_bf16(b[0], b[1]); r.w = cvt_pk_bf16(b[2], b[3]);
    return __builtin_bit_cast(bf16x8, r);
}
__device__ __forceinline__ bf16x8 ld8(const bf16_t* p) { return *(const bf16x8*)p; }
__device__ __forceinline__ bf16x8 ld44(const bf16_t* p0, const bf16_t* p1) {
    u32x2 a = *(const u32x2*)p0, b = *(const u32x2*)p1; u32x4 r; r.x = a.x; r.y = a.y; r.z = b.x; r.w = b.y; return __builtin_bit_cast(bf16x8, r);
}
__device__ __forceinline__ float wave_sum(float v) {
    v += __shfl_xor(v, 32); v += __shfl_xor(v, 16); v += __shfl_xor(v, 8); v += __shfl_xor(v, 4); v += __shfl_xor(v, 2); v += __shfl_xor(v, 1); return v;
}
__device__ __forceinline__ float half_sum(float v) {
    v += __shfl_xor(v, 16); v += __shfl_xor(v, 8); v += __shfl_xor(v, 4); v += __shfl_xor(v, 2); v += __shfl_xor(v, 1); return v;
}
__device__ __forceinline__ float wave_max(float v) {
    v = fmaxf(v, __shfl_xor(v, 32)); v = fmaxf(v, __shfl_xor(v, 16)); v = fmaxf(v, __shfl_xor(v, 8)); v = fmaxf(v, __shfl_xor(v, 4)); v = fmaxf(v, __shfl_xor(v, 2)); v = fmaxf(v, __shfl_xor(v, 1)); return v;
}

__device__ __forceinline__ int opaque_tid() { int t = threadIdx.x; asm volatile("" : "+v"(t)); return t; }

__device__ __forceinline__ void convert_tile(const float* W, int K, int N, bf16_t* Wt, int mode, int tile, char* lds) {
    float* T = (float*)lds;
    const int nkt = K >> 6, tk = tile % nkt, tn = tile / nkt, k0 = tk * 64, n0 = tn * 128, tid = opaque_tid();
    {
        const int nl = (tid & 31) * 4, np = n0 + nl;
        int src = np;
        if (mode == 1) { const int g = np >> 5, w = np & 31; src = (w < 16) ? g * 16 + w : DFF + g * 16 + (w - 16); }
        const bool ok = (mode == 1) ? true : (np < N);
        f32x4 v[8];
#pragma unroll
        for (int i = 0; i < 8; ++i) { const int kl = (tid >> 5) + 8 * i; v[i] = (f32x4){0.f, 0.f, 0.f, 0.f}; if (ok) v[i] = *(const f32x4*)(W + (size_t)(k0 + kl) * N + src); }
#pragma unroll
        for (int i = 0; i < 8; ++i) { const int kl = (tid >> 5) + 8 * i; T[kl * 129 + nl] = v[i][0]; T[kl * 129 + nl + 1] = v[i][1]; T[kl * 129 + nl + 2] = v[i][2]; T[kl * 129 + nl + 3] = v[i][3]; }
    }
    __syncthreads();
    {
        const int kp = tid & 31;
#pragma unroll 4
        for (int i = 0; i < 16; ++i) { const int nl = (tid >> 5) + 8 * i; *(unsigned*)(Wt + (size_t)(n0 + nl) * K + k0 + 2 * kp) = cvt_pk_bf16(T[(2 * kp) * 129 + nl], T[(2 * kp + 1) * 129 + nl]); }
    }
    __syncthreads();
}

__device__ __forceinline__ void mod_tile(const Params& p, int item, char* lds) {
    float* sc = (float*)lds;
    const int tid = opaque_tid(), l = item / 144, c0 = (item % 144) * 64;
    for (int i = tid; i < 9 * 1024; i += 256) { const float v = (i < 8192) ? p.c[i] : p.c_ctx[i - 8192]; sc[i] = siluf(v); }
    __syncthreads();
    const int cgp = tid & 15, kg = tid >> 4;
    f32x4 acc[9];
#pragma unroll
    for (int r = 0; r < 9; ++r) acc[r] = (f32x4){0.f, 0.f, 0.f, 0.f};
    const float* Wp = p.w_mod + (size_t)l * 1024 * 9216 + c0 + cgp * 4;
#pragma unroll 16
    for (int kk = 0; kk < 64; ++kk) {
        const int k = kg * 64 + kk;
        const f32x4 w = *(const f32x4*)(Wp + (size_t)k * 9216);
#pragma unroll
        for (int r = 0; r < 9; ++r) acc[r] += w * sc[r * 1024 + k];
    }
    __syncthreads();
    float* red = (float*)lds;
#pragma unroll
    for (int r = 0; r < 9; ++r) *(f32x4*)(red + (kg * 9 + r) * 64 + cgp * 4) = acc[r];
    __syncthreads();
    float* MOD = (float*)(p.ws + OFF_MOD);
    for (int o = tid; o < 9 * 64; o += 256) {
        const int r = o >> 6, cc = o & 63; float s = 0.f;
#pragma unroll
        for (int g = 0; g < 16; ++g) s += red[(g * 9 + r) * 64 + cc];
        MOD[((size_t)l * 9 + r) * 9216 + c0 + cc] = s + p.b_mod[(size_t)l * 9216 + c0 + cc];
    }
    __syncthreads();
}

__device__ __forceinline__ void norm_phase(const Params& p, int layer, int midx, bool skip_ctx) {
    const float* H = (const float*)(p.ws + OFF_H);
    bf16_t* HN = (bf16_t*)(p.ws + OFF_HN);
    const float* MOD = (const float*)(p.ws + OFF_MOD) + (size_t)layer * 9 * 9216;
    const int tidn = opaque_tid();
    const int lane = tidn & 63, gw = blockIdx.x * 4 + (tidn >> 6), nw = gridDim.x * 4;
    for (int rb = gw * 9; rb < M; rb += nw * 9) {
        f32x4 v[9][4]; bool ok[9]; int mrr[9];
#pragma unroll
        for (int u = 0; u < 9; ++u) {
            const int row = rb + u;
            const int rr = row < M ? row : M - 1;
            const int b = rr / TB, t = rr - b * TB;
            ok[u] = (row < M) && !(skip_ctx && t < TC);
            mrr[u] = (t < TC) ? 8 : b;
            if (ok[u]) {
#pragma unroll
                for (int i = 0; i < 4; ++i) v[u][i] = *(const f32x4*)(H + (size_t)rr * D + lane * 4 + i * 256);
            }
        }
        int cur = -1; f32x4 s4[4], c4[4];
#pragma unroll
        for (int u = 0; u < 9; ++u) {
            if (!ok[u]) continue;
            if (mrr[u] != cur) {
                cur = mrr[u];
                const float* sh = MOD + (size_t)cur * 9216 + midx * 1024;
#pragma unroll
                for (int i = 0; i < 4; ++i) { s4[i] = *(const f32x4*)(sh + lane * 4 + i * 256); c4[i] = *(const f32x4*)(sh + 1024 + lane * 4 + i * 256); }
            }
        }
        asm volatile("" ::: "memory");
#pragma unroll
        for (int u = 0; u < 9; ++u) {
            if (!ok[u]) continue;
            if (mrr[u] != cur) {
                cur = mrr[u];
                const float* sh = MOD + (size_t)cur * 9216 + midx * 1024;
#pragma unroll
                for (int i = 0; i < 4; ++i) { s4[i] = *(const f32x4*)(sh + lane * 4 + i * 256); c4[i] = *(const f32x4*)(sh + 1024 + lane * 4 + i * 256); }
            }
            float ss = 0.f;
#pragma unroll
            for (int i = 0; i < 4; ++i) ss += v[u][i][0] * v[u][i][0] + v[u][i][1] * v[u][i][1] + v[u][i][2] * v[u][i][2] + v[u][i][3] * v[u][i][3];
            const float r = rsqrtf(wave_sum(ss) * (1.f / 1024.f) + EPS);
            const int row = rb + u;
#pragma unroll
            for (int i = 0; i < 4; ++i) {
                u32x2 o; o.x = cvt_pk_bf16(v[u][i][0] * r * (1.f + c4[i][0]) + s4[i][0], v[u][i][1] * r * (1.f + c4[i][1]) + s4[i][1]);
                o.y = cvt_pk_bf16(v[u][i][2] * r * (1.f + c4[i][2]) + s4[i][2], v[u][i][3] * r * (1.f + c4[i][3]) + s4[i][3]);
                *(u32x2*)(HN + (size_t)row * D + lane * 4 + i * 256) = o;
            }
        }
    }
}

struct EpiArgs { bf16_t* obf; float* H; float* outp; const float* gate; float gscale; int ldo; };
template <int EPI>
__device__ __forceinline__ void gemm_phase(const bf16_t* A, const bf16_t* Bt, int K, int nN, bool skip_ctx, const EpiArgs e, char* lds) {
    const int tid = opaque_tid(), lane = tid & 63, w = tid >> 6, wm = w >> 1, wn = w & 1, l15 = lane & 15, quad = lane >> 4;
    const int ntm = skip_ctx ? 128 : 144, ntiles = ntm * nN, nk = K >> 6;
    const int woff = (tid >> 3) * 128 + ((((tid & 7) ^ ((tid >> 4) & 7))) << 4);
    int aoff[4][2], boff[4][2];
#pragma unroll
    for (int t = 0; t < 4; ++t)
#pragma unroll
        for (int ks = 0; ks < 2; ++ks) {
            aoff[t][ks] = (wm * 64 + t * 16 + l15) * 128 + ((((ks * 4 + quad) ^ (l15 >> 1))) << 4);
            boff[t][ks] = 16384 + (wn * 64 + t * 16 + l15) * 128 + ((((ks * 4 + quad) ^ (l15 >> 1))) << 4);
        }
    const int xcd = blockIdx.x & 7, lblk = blockIdx.x >> 3, nlb = gridDim.x >> 3, ntmx = ntm >> 3, ntx = ntmx * nN, nfull = (nN >> 3) << 3;
    (void)ntiles;
    for (int lt = lblk; lt < ntx; lt += nlb) {
        int tml, tn;
        if (lt < ntmx * nfull) { const int g = lt / (ntmx * 8), rem = lt - g * (ntmx * 8); tml = rem >> 3; tn = g * 8 + (rem & 7); }
        else { const int l2 = lt - ntmx * nfull, gw = nN - nfull; tml = l2 / gw; tn = nfull + (l2 - tml * gw); }
        const int tmi = xcd * ntmx + tml;
        const int tm = skip_ctx ? (tmi >> 4) * 18 + 2 + (tmi & 15) : tmi;
        const int m0 = tm * 128, n0 = tn * 128;
        const bf16_t* ag = A + (size_t)(m0 + (tid >> 3)) * K + (tid & 7) * 8;
        const bf16_t* bg = Bt + (size_t)(n0 + (tid >> 3)) * K + (tid & 7) * 8;
        f32x4 acc[4][4];
#pragma unroll
        for (int i = 0; i < 4; ++i)
#pragma unroll
            for (int j = 0; j < 4; ++j) acc[i][j] = (f32x4){0.f, 0.f, 0.f, 0.f};
        u32x4 ra0[4], rb0[4], ra1[4], rb1[4];
#define GLOAD(RA, RB, KT) do { _Pragma("unroll") for (int i = 0; i < 4; ++i) { RA[i] = *(const u32x4*)(ag + (size_t)i * 32 * K + (KT) * 64); RB[i] = *(const u32x4*)(bg + (size_t)i * 32 * K + (KT) * 64); } } while (0)
#define LSTORE(RA, RB, BUF) do { _Pragma("unroll") for (int i = 0; i < 4; ++i) { *(u32x4*)((BUF) + woff + i * 4096) = RA[i]; *(u32x4*)((BUF) + 16384 + woff + i * 4096) = RB[i]; } } while (0)
#define COMPUTE(BUF) do { _Pragma("unroll") for (int ks = 0; ks < 2; ++ks) { bf16x8 af[4], bfr[4]; \
            _Pragma("unroll") for (int t = 0; t < 4; ++t) { af[t] = *(const bf16x8*)((BUF) + aoff[t][ks]); bfr[t] = *(const bf16x8*)((BUF) + boff[t][ks]); } \
            __builtin_amdgcn_s_setprio(1); \
            _Pragma("unroll") for (int mt = 0; mt < 4; ++mt) _Pragma("unroll") for (int nt = 0; nt < 4; ++nt) acc[mt][nt] = mfma16(bfr[nt], af[mt], acc[mt][nt]); \
            __builtin_amdgcn_s_setprio(0); } } while (0)
        GLOAD(ra0, rb0, 0);
        GLOAD(ra1, rb1, 1);
        LSTORE(ra0, rb0, lds);
        __syncthreads();
        for (int kt = 0; kt < nk; kt += 2) {
            if (kt + 2 < nk) GLOAD(ra0, rb0, kt + 2);
            COMPUTE(lds);
            LSTORE(ra1, rb1, lds + 32768);
            __syncthreads();
            if (kt + 3 < nk) GLOAD(ra1, rb1, kt + 3);
            COMPUTE(lds + 32768);
            if (kt + 2 < nk) LSTORE(ra0, rb0, lds);
            __syncthreads();
        }
#undef GLOAD
#undef LSTORE
#undef COMPUTE
#pragma unroll
        for (int mt = 0; mt < 4; ++mt) {
            const int row = m0 + wm * 64 + mt * 16 + l15;
            const int b = row / TB, t = row - b * TB;
            if (EPI == 0) {
#pragma unroll
                for (int nt = 0; nt < 4; nt += 2) {
                    const int hc = ((n0 + wn * 64 + nt * 16) >> 1) + quad * 4;
                    const f32x4 g = acc[mt][nt], u = acc[mt][nt + 1];
                    u32x2 o; o.x = cvt_pk_bf16(siluf(g[0]) * u[0], siluf(g[1]) * u[1]); o.y = cvt_pk_bf16(siluf(g[2]) * u[2], siluf(g[3]) * u[3]);
                    *(u32x2*)(e.obf + (size_t)row * DFF + hc) = o;
                }
            } else if (EPI == 2) {
#pragma unroll
                for (int nt = 0; nt < 4; ++nt) {
                    const int col = n0 + wn * 64 + nt * 16 + quad * 4;
                    u32x2 o; o.x = cvt_pk_bf16(acc[mt][nt][0], acc[mt][nt][1]); o.y = cvt_pk_bf16(acc[mt][nt][2], acc[mt][nt][3]);
                    *(u32x2*)(e.obf + (size_t)row * e.ldo + col) = o;
                }
            } else {
                const int mr = (t < TC) ? 8 : b;
                const float* gp = e.gate + (size_t)mr * 9216;
#pragma unroll
                for (int nt = 0; nt < 4; ++nt) {
                    const int col = n0 + wn * 64 + nt * 16 + quad * 4;
                    const f32x4 gv = *(const f32x4*)(gp + col);
                    f32x4 h = *(const f32x4*)(e.H + (size_t)row * D + col);
                    h += (gv * e.gscale) * acc[mt][nt];
                    if (e.outp == nullptr) *(f32x4*)(e.H + (size_t)row * D + col) = h;
                    else if (t >= TC) *(f32x4*)(e.outp + ((size_t)b * TL + (t - TC)) * D + col) = h;
                }
            }
        }
    }
}

template <int EPI>
__device__ __forceinline__ void gemm256_phase(const bf16_t* A, const bf16_t* Bt, int K, int nN, bool skip_ctx, const EpiArgs e, char* lds) {
    const int tid = opaque_tid(), lane = tid & 63, w = tid >> 6, wm = w >> 1, wn = w & 1, l15 = lane & 15, quad = lane >> 4;
    const int nk = K >> 5;
    const int gsel_w = (tid >> 4) & 3, gw = (gsel_w == 0) ? 0 : (gsel_w == 1) ? 2 : (gsel_w == 2) ? 3 : 1;
    const int woff = (tid >> 2) * 64 + (((tid & 3) ^ gw) << 4);
    const int gsel_r = (l15 >> 2) & 3, gr = (gsel_r == 0) ? 0 : (gsel_r == 1) ? 2 : (gsel_r == 2) ? 3 : 1;
    const int aoff = (wm * 128 + l15) * 64 + ((quad ^ gr) << 4);
    const int boff = 16384 + (wn * 64 + l15) * 64 + ((quad ^ gr) << 4);
    const int ntm = skip_ctx ? 64 : 72;
    const int xcd = blockIdx.x & 7, lblk = blockIdx.x >> 3, nlb = gridDim.x >> 3, ntmx = ntm >> 3, ntx = ntmx * nN, nfull = (nN >> 3) << 3;
    for (int lt = lblk; lt < ntx; lt += nlb) {
        int tml, tn;
        if (lt < ntmx * nfull) { const int g = lt / (ntmx * 8), rem = lt - g * (ntmx * 8); tml = rem >> 3; tn = g * 8 + (rem & 7); }
        else { const int l2 = lt - ntmx * nfull, gwd = nN - nfull; tml = l2 / gwd; tn = nfull + (l2 - tml * gwd); }
        const int tmi = xcd * ntmx + tml;
        const int tm = skip_ctx ? (tmi >> 3) * 9 + 1 + (tmi & 7) : tmi;
        const int m0 = tm * 256, n0 = tn * 128;
        const bf16_t* ag = A + (size_t)(m0 + (tid >> 2)) * K + (tid & 3) * 8;
        const bf16_t* bg = Bt + (size_t)(n0 + (tid >> 2)) * K + (tid & 3) * 8;
        f32x4 acc[8][4];
#pragma unroll
        for (int i = 0; i < 8; ++i)
#pragma unroll
            for (int j = 0; j < 4; ++j) acc[i][j] = (f32x4){0.f, 0.f, 0.f, 0.f};
        u32x4 ra0[4], rb0[2], ra1[4], rb1[2];
#define G2LOAD(RA, RB, KT) do { _Pragma("unroll") for (int i = 0; i < 4; ++i) RA[i] = *(const u32x4*)(ag + (size_t)i * 64 * K + (KT) * 32); \
                        _Pragma("unroll") for (int i = 0; i < 2; ++i) RB[i] = *(const u32x4*)(bg + (size_t)i * 64 * K + (KT) * 32); } while (0)
#define L2STORE(RA, RB, BUF) do { _Pragma("unroll") for (int i = 0; i < 4; ++i) *(u32x4*)((BUF) + woff + i * 4096) = RA[i]; \
                          _Pragma("unroll") for (int i = 0; i < 2; ++i) *(u32x4*)((BUF) + 16384 + woff + i * 4096) = RB[i]; } while (0)
#define C2MPUTE(BUF) do { bf16x8 bfr[4], af[4]; \
            _Pragma("unroll") for (int t = 0; t < 4; ++t) { bfr[t] = *(const bf16x8*)((BUF) + boff + t * 1024); af[t] = *(const bf16x8*)((BUF) + aoff + t * 1024); } \
            __builtin_amdgcn_s_setprio(1); \
            _Pragma("unroll") for (int mt = 0; mt < 4; ++mt) _Pragma("unroll") for (int nt = 0; nt < 4; ++nt) acc[mt][nt] = mfma16(bfr[nt], af[mt], acc[mt][nt]); \
            __builtin_amdgcn_s_setprio(0); \
            _Pragma("unroll") for (int t = 0; t < 4; ++t) af[t] = *(const bf16x8*)((BUF) + aoff + (4 + t) * 1024); \
            __builtin_amdgcn_s_setprio(1); \
            _Pragma("unroll") for (int mt = 0; mt < 4; ++mt) _Pragma("unroll") for (int nt = 0; nt < 4; ++nt) acc[4 + mt][nt] = mfma16(bfr[nt], af[mt], acc[4 + mt][nt]); \
            __builtin_amdgcn_s_setprio(0); } while (0)
        G2LOAD(ra0, rb0, 0);
        G2LOAD(ra1, rb1, 1);
        L2STORE(ra0, rb0, lds);
        __syncthreads();
        for (int kt = 0; kt < nk; kt += 2) {
            if (kt + 2 < nk) G2LOAD(ra0, rb0, kt + 2);
            C2MPUTE(lds);
            L2STORE(ra1, rb1, lds + 24576);
            __syncthreads();
            if (kt + 3 < nk) G2LOAD(ra1, rb1, kt + 3);
            C2MPUTE(lds + 24576);
            if (kt + 2 < nk) L2STORE(ra0, rb0, lds);
            __syncthreads();
        }
#undef G2LOAD
#undef L2STORE
#undef C2MPUTE
#pragma unroll
        for (int mt = 0; mt < 8; ++mt) {
            const int row = m0 + wm * 128 + mt * 16 + l15;
            if (EPI == 0) {
#pragma unroll
                for (int nt = 0; nt < 4; nt += 2) {
                    const int hc = ((n0 + wn * 64 + nt * 16) >> 1) + quad * 4;
                    const f32x4 g = acc[mt][nt], u = acc[mt][nt + 1];
                    u32x2 o; o.x = cvt_pk_bf16(siluf(g[0]) * u[0], siluf(g[1]) * u[1]); o.y = cvt_pk_bf16(siluf(g[2]) * u[2], siluf(g[3]) * u[3]);
                    *(u32x2*)(e.obf + (size_t)row * DFF + hc) = o;
                }
            } else {
#pragma unroll
                for (int nt = 0; nt < 4; ++nt) {
                    const int col = n0 + wn * 64 + nt * 16 + quad * 4;
                    u32x2 o; o.x = cvt_pk_bf16(acc[mt][nt][0], acc[mt][nt][1]); o.y = cvt_pk_bf16(acc[mt][nt][2], acc[mt][nt][3]);
                    *(u32x2*)(e.obf + (size_t)row * e.ldo + col) = o;
                }
            }
        }
    }
}

__device__ __forceinline__ int kpos(int x) { return (x & 32) + (((x & 15) >> 2) * 8 + ((x >> 4) & 1) * 4 + (x & 3)); }
__device__ __forceinline__ size_t vt_off(int dv, int t) { const int w = t & 31; return ((size_t)(t >> 5) * 64 + dv) * 32 + (((w & 15) >> 2) * 8 + ((w >> 4) & 1) * 4 + (w & 3)); }
__device__ __forceinline__ void ld8f(const bf16_t* p, float (&x)[8]) {
    const u32x4 v = *(const u32x4*)p;
    x[0] = bflo(v.x); x[1] = bfhi(v.x); x[2] = bflo(v.y); x[3] = bfhi(v.y); x[4] = bflo(v.z); x[5] = bfhi(v.z); x[6] = bflo(v.w); x[7] = bfhi(v.w);
}
__device__ __forceinline__ void st8f(bf16_t* p, const float (&y)[8]) {
    u32x4 o; o.x = cvt_pk_bf16(y[0], y[1]); o.y = cvt_pk_bf16(y[2], y[3]); o.z = cvt_pk_bf16(y[4], y[5]); o.w = cvt_pk_bf16(y[6], y[7]);
    *(u32x4*)p = o;
}
__device__ __forceinline__ void prep_phase(const Params& p, int layer, char* lds) {
    const bf16_t* P = (const bf16_t*)(p.ws + OFF_BIG);
    char* dob = (char*)p.out;
    bf16_t *QA = (bf16_t*)(dob + DO_QA), *KA = (bf16_t*)(dob + DO_KA), *VAT = (bf16_t*)(dob + DO_VAT), *QB = (bf16_t*)(dob + DO_QB), *KB = (bf16_t*)(dob + DO_KB), *VBT = (bf16_t*)(dob + DO_VBT);
    bf16_t *QC = (bf16_t*)(p.ws + OFF_QC), *KC = (bf16_t*)(p.ws + OFF_KC), *VC = (bf16_t*)(p.ws + OFF_VC);
    bf16_t* Y = (bf16_t*)(p.ws + OFF_HN);
    float *G = (float*)(p.ws + OFF_G), *BETA = (float*)(p.ws + OFF_BETA);
    const float *aq = p.a_qnorm + layer * 32, *ak = p.a_knorm + layer * 32, *bq = p.b_qnorm + layer * 64, *bk = p.b_knorm + layer * 64;
    const float *cw = p.c_conv + (size_t)layer * 5 * 1152, *alog = p.c_A_log + layer * 12, *dtb = p.c_dt_bias + layer * 12;
    const int tid = opaque_tid(), lane = tid & 63, w = tid >> 6;
    unsigned* TT = (unsigned*)lds;
    float* CW = (float*)(lds + 12544);
    float* RA = (float*)(lds + 12544 + 23040);
    float* RB = RA + 1024;
    for (int i = tid; i < 5 * 1152; i += 256) CW[i] = cw[i];
    for (int i = tid; i < 512; i += 256) { const int pos = i >> 3, f = i & 7; float sn, cs; sincosf((float)pos * exp2f(-(float)f * (13.287712379549449f / 8.f)), &sn, &cs); RA[i * 2] = cs; RA[i * 2 + 1] = sn; }
    for (int i = tid; i < 1024; i += 256) { const int pos = i >> 4, f = i & 15; float sn, cs; sincosf((float)pos * exp2f(-(float)f * (13.287712379549449f / 16.f)), &sn, &cs); RB[i * 2] = cs; RB[i * 2 + 1] = sn; }
    __syncthreads();
    for (int tile = blockIdx.x; tile < M / 16; tile += gridDim.x) {
        const int row0 = tile * 16, b = row0 / TB, t0 = row0 - b * TB;
        const bool is_ctx = t0 < TC;
        for (int idx = tid; idx < 16 * 192; idx += 256) {
            const int tok = idx / 192, cp = idx - tok * 192, c2 = cp * 2;
            const int col = (c2 < 256) ? 512 + c2 : 1280 + (c2 - 256);
            TT[tok * 193 + cp] = *(const unsigned*)(P + (size_t)(row0 + tok) * NINP + col);
        }
#pragma unroll 2
        for (int task = w; task < 32; task += 4) {
            const int tok = task >> 1, isB = task & 1, row = row0 + tok, t = t0 + tok, tl = t - TC;
            const int prow_pos = tl >> 6, pcol_pos = tl & 63;
            const bf16_t* prow = P + (size_t)row * NINP;
            float x[8], y[8];
            if (!isB) {
                const int c = lane;
                const bool isq = c < 32; const int hh = (c >> 3) & 3, mp = (c >> 2) & 1, cc = c & 3;
                ld8f(prow + c * 8, x);
                float ss = 0.f;
#pragma unroll
                for (int j = 0; j < 8; ++j) ss += x[j] * x[j];
                ss += __shfl_xor(ss, 1); ss += __shfl_xor(ss, 2);
                const float r = rsqrtf(ss * (1.f / 32.f) + EPS);
                const float* wn = (isq ? aq : ak) + cc * 8;
#pragma unroll
                for (int j = 0; j < 8; ++j) y[j] = x[j] * r * wn[j];
                if (!is_ctx) {
                    const float* tb = RA + ((cc < 2 ? prow_pos : pcol_pos) * 8) * 2;
#pragma unroll
                    for (int j = 0; j < 8; ++j) {
                        const float pr = __shfl_xor(y[j], 1), cs = tb[j * 2], sn = tb[j * 2 + 1];
                        y[j] = y[j] * cs + pr * ((cc & 1) ? sn : -sn);
                    }
                }
                st8f((isq ? QA : KA) + ((size_t)((b * 4 + hh) * 2 + mp) * TB + t) * 32 + cc * 8, y);
            } else {
                const int c = lane;
                const bool isq = c < 48; const int hh = isq ? (c >> 3) : ((c - 48) >> 3), cc = c & 7;
                ld8f(prow + 768 + c * 8, x);
                float ss = 0.f;
#pragma unroll
                for (int j = 0; j < 8; ++j) ss += x[j] * x[j];
                ss += __shfl_xor(ss, 1); ss += __shfl_xor(ss, 2); ss += __shfl_xor(ss, 4);
                const float r = rsqrtf(ss * (1.f / 64.f) + EPS);
                const float* wn = (isq ? bq : bk) + cc * 8;
#pragma unroll
                for (int j = 0; j < 8; ++j) y[j] = x[j] * r * wn[j];
                if (!is_ctx) {
                    const float* tb = RB + ((cc < 4 ? prow_pos : pcol_pos) * 16 + (cc & 1) * 8) * 2;
#pragma unroll
                    for (int j = 0; j < 8; ++j) {
                        const float pr = __shfl_xor(y[j], 2), cs = tb[j * 2], sn = tb[j * 2 + 1];
                        y[j] = y[j] * cs + pr * ((cc & 2) ? sn : -sn);
                    }
                }
                st8f((isq ? QB + ((size_t)(b * 6 + hh) * TB + t) * 64 : KB + ((size_t)(b * 2 + hh) * TB + t) * 64) + cc * 8, y);
            }
        }
#pragma unroll 2
        for (int task = w; task < 48; task += 4) {
            const int tok = task / 3, cidx = (task - tok * 3) * 64 + lane, row = row0 + tok, t = t0 + tok;
            if (cidx < 144) {
                const int part = cidx / 48, hh = (cidx - part * 48) >> 3, cc = cidx & 7;
                const int ts = is_ctx ? 0 : TC, len = is_ctx ? TC : TL, tq = t - ts;
                float a[8];
#pragma unroll
                for (int j = 0; j < 8; ++j) a[j] = 0.f;
#pragma unroll
                for (int i = 0; i < 5; ++i) {
                    const int tt = tq + i - 2;
                    if (tt >= 0 && tt < len) {
                        float x[8]; ld8f(P + (size_t)(row + i - 2) * NINP + 1408 + cidx * 8, x);
                        const f32x4 w0 = *(const f32x4*)(CW + i * 1152 + cidx * 8), w1 = *(const f32x4*)(CW + i * 1152 + cidx * 8 + 4);
                        a[0] += w0[0] * x[0]; a[1] += w0[1] * x[1]; a[2] += w0[2] * x[2]; a[3] += w0[3] * x[3];
                        a[4] += w1[0] * x[4]; a[5] += w1[1] * x[5]; a[6] += w1[2] * x[6]; a[7] += w1[3] * x[7];
                    }
                }
                float ss = 0.f;
#pragma unroll
                for (int j = 0; j < 8; ++j) { a[j] = siluf(a[j]); ss += a[j] * a[j]; }
                ss += __shfl_xor(ss, 1); ss += __shfl_xor(ss, 2); ss += __shfl_xor(ss, 4);
                if (part < 2) {
                    const float r = rsqrtf(ss + EPS) * (part == 0 ? 0.125f : 1.f);
#pragma unroll
                    for (int j = 0; j < 8; ++j) a[j] *= r;
                }
                if (part == 2) st8f(VC + (size_t)row * 384 + hh * 64 + cc * 8, a);
                else {
                    bf16_t* dst = (part == 0 ? QC : KC) + (size_t)row * 384 + hh * 64;
                    u32x2 o0, o1; o0.x = cvt_pk_bf16(a[0], a[1]); o0.y = cvt_pk_bf16(a[2], a[3]); o1.x = cvt_pk_bf16(a[4], a[5]); o1.y = cvt_pk_bf16(a[6], a[7]);
                    *(u32x2*)(dst + kpos(cc * 8)) = o0; *(u32x2*)(dst + kpos(cc * 8 + 4)) = o1;
                }
            }
        }
        for (int idx = tid; idx < 16 * 24; idx += 256) {
            const int tok = idx / 24, j = idx - tok * 24, row = row0 + tok;
            if (j < 12) {
                const float a = bf2f(P[(size_t)row * NINP + 2944 + j]) + dtb[j];
                const float sp = fmaxf(a, 0.f) + log1pf(__expf(-fabsf(a)));
                G[(size_t)row * 12 + j] = -__expf(alog[j]) * sp;
            } else {
                const float bb = bf2f(P[(size_t)row * NINP + 2956 + (j - 12)]);
                BETA[(size_t)row * 12 + (j - 12)] = 1.f / (1.f + __expf(-bb));
            }
        }
        for (int idx = tid; idx < 16 * 48; idx += 256) {
            const int tok = idx / 48, cp = idx - tok * 48;
            float x[8]; ld8f(P + (size_t)(row0 + tok) * NINP + 2560 + cp * 8, x);
#pragma unroll
            for (int j = 0; j < 8; ++j) x[j] = siluf(x[j]);
            st8f(Y + (size_t)(row0 + tok) * D + 640 + cp * 8, x);
        }
        __syncthreads();
        {
            const int tok = tid & 15;
            for (int cidx = tid >> 4; cidx < 384; cidx += 16) {
                const unsigned v2 = TT[tok * 193 + (cidx >> 1)];
                const bf16_t v = (cidx & 1) ? (bf16_t)(v2 >> 16) : (bf16_t)(v2 & 0xffff);
                if (cidx < 256) VAT[(size_t)(b * 4 + (cidx >> 6)) * 64 * TB + vt_off(cidx & 63, t0 + tok)] = v;
                else { const int c2 = cidx - 256; VBT[(size_t)(b * 2 + (c2 >> 6)) * 64 * TB + vt_off(c2 & 63, t0 + tok)] = v; }
            }
        }
        __syncthreads();
    }
}

template <int DQK>
__device__ __forceinline__ void attn_wave(const bf16_t* Q, const bf16_t* Kp, const bf16_t* VT, int qt0, int kbeg, int kend, int k2beg, int k2end,
                                          float c1, float c2, f32x4 (&acc)[2][4], float (&lsum)[2], int lane) {
    constexpr int KS = DQK / 32;
    const int l15 = lane & 15, quad = lane >> 4;
    bf16x8 qf[2][KS];
#pragma unroll
    for (int qt = 0; qt < 2; ++qt)
#pragma unroll
        for (int ks = 0; ks < KS; ++ks) qf[qt][ks] = ld8(Q + (size_t)(qt0 + qt * 16 + l15) * DQK + ks * 32 + quad * 8);
    const bf16_t* kbase = Kp + (size_t)l15 * DQK + quad * 8;
    const bf16_t* vbase = VT + (size_t)l15 * 32 + quad * 8;
#pragma unroll 1
    for (int rg = 0; rg < 2; ++rg) {
        const int kb0 = rg ? k2beg : kbeg, kb1 = rg ? k2end : kend;
        const bool band = rg != 0;
        if (kb0 >= kb1) continue;
        bf16x8 kf[2][KS], vf[4];
#pragma unroll
        for (int kt = 0; kt < 2; ++kt)
#pragma unroll
            for (int ks = 0; ks < KS; ++ks) kf[kt][ks] = ld8(kbase + (size_t)(kb0 + kt * 16) * DQK + ks * 32);
#pragma unroll
        for (int dt = 0; dt < 4; ++dt) vf[dt] = ld8(vbase + (size_t)(kb0 >> 5) * 2048 + dt * 512);
#pragma unroll 1
        for (int kb = kb0; kb < kb1; kb += 32) {
            const int kn = (kb + 32 < kb1) ? kb + 32 : kb;
            bf16x8 kfn[2][KS], vfn[4];
#pragma unroll
            for (int kt = 0; kt < 2; ++kt)
#pragma unroll
                for (int ks = 0; ks < KS; ++ks) kfn[kt][ks] = ld8(kbase + (size_t)(kn + kt * 16) * DQK + ks * 32);
#pragma unroll
            for (int dt = 0; dt < 4; ++dt) vfn[dt] = ld8(vbase + (size_t)(kn >> 5) * 2048 + dt * 512);
#pragma unroll
            for (int qt = 0; qt < 2; ++qt) {
                f32x4 s[2];
#pragma unroll
                for (int kt = 0; kt < 2; ++kt) {
                    s[kt] = (f32x4){0.f, 0.f, 0.f, 0.f};
#pragma unroll
                    for (int ks = 0; ks < KS; ++ks) s[kt] = mfma16(kf[kt][ks], qf[qt][ks], s[kt]);
                }
                float ps = 0.f;
#pragma unroll
                for (int kt = 0; kt < 2; ++kt)
#pragma unroll
                    for (int j = 0; j < 4; ++j) {
                        float pv = __builtin_amdgcn_exp2f(s[kt][j] * c1 - c2);
                        if (band) {
                            const int dd = (qt0 + qt * 16 + l15) - (kb + kt * 16 + quad * 4 + j);
                            if (dd > 128 || dd < -128) pv = 0.f;
                        }
                        s[kt][j] = pv; ps += pv;
                    }
                lsum[qt] += ps;
                const bf16x8 pf = pack8(s[0], s[1]);
#pragma unroll
                for (int dt = 0; dt < 4; ++dt) acc[qt][dt] = mfma16(vf[dt], pf, acc[qt][dt]);
            }
#pragma unroll
            for (int kt = 0; kt < 2; ++kt)
#pragma unroll
                for (int ks = 0; ks < KS; ++ks) kf[kt][ks] = kfn[kt][ks];
#pragma unroll
            for (int dt = 0; dt < 4; ++dt) vf[dt] = vfn[dt];
        }
    }
}

__device__ __forceinline__ void attnA_item(const Params& p, int layer, int b, int h, int qt_first  , int kend, float lam_init, char* lds) {
    char* dob = (char*)p.out;
    const bf16_t *QA = (const bf16_t*)(dob + DO_QA), *KA = (const bf16_t*)(dob + DO_KA), *VAT = (const bf16_t*)(dob + DO_VAT);
    bf16_t* Y = (bf16_t*)(p.ws + OFF_HN);
    const int tida = opaque_tid();
    const int lane = tida & 63, w = tida >> 6, l15 = lane & 15, quad = lane >> 4;
    const float* lf = p.a_lambda + layer * 128;
    float sa = 0.f, sb = 0.f;
    if (lane < 32) { sa = lf[lane] * lf[32 + lane]; sb = lf[64 + lane] * lf[96 + lane]; }
    sa = wave_sum(sa); sb = wave_sum(sb);
    const float lam = __expf(sa) - __expf(sb) + lam_init;
    const float mq = wave_max(fabsf(p.a_qnorm[layer * 32 + (lane & 31)])), mk = wave_max(fabsf(p.a_knorm[layer * 32 + (lane & 31)]));
    const float scale = 0.17677669529663687f;
    const float c1 = scale * LOG2E, c2 = 32.f * mq * mk * scale * LOG2E;
    const int qt0 = qt_first + w * 32;
    const size_t ho = (size_t)((b * 4 + h) * 2) * TB * 32, mo = (size_t)TB * 32;
    f32x4 acc[2][2][4]; float ls[2][2];
    bf16x8 qf[2][2];
#pragma unroll
    for (int m = 0; m < 2; ++m)
#pragma unroll
        for (int qt = 0; qt < 2; ++qt) {
            ls[m][qt] = 0.f;
            qf[m][qt] = ld8(QA + ho + m * mo + (size_t)(qt0 + qt * 16 + l15) * 32 + quad * 8);
#pragma unroll
            for (int dt = 0; dt < 4; ++dt) acc[m][qt][dt] = (f32x4){0.f, 0.f, 0.f, 0.f};
        }
    const int gsw = (tida >> 4) & 3, gws = (gsw == 0) ? 0 : (gsw == 1) ? 2 : (gsw == 2) ? 3 : 1;
    const int srow = (tida >> 2) & 63, sch = tida & 3;
    const bf16_t* kg = KA + ho + (size_t)(tida >> 7) * mo + (size_t)((tida >> 2) & 31) * 32 + sch * 8;
    const bf16_t* vg = VAT + (size_t)(b * 4 + h) * 64 * TB + (size_t)srow * 32 + sch * 8;
    const int kw = (tida >> 7) * 2048 + ((tida >> 2) & 31) * 64 + ((sch ^ gws) << 4);
    const int vw = 4096 + srow * 64 + ((sch ^ gws) << 4);
    const int gsr = (l15 >> 2) & 3, grs = (gsr == 0) ? 0 : (gsr == 1) ? 2 : (gsr == 2) ? 3 : 1;
    const int fo = l15 * 64 + ((quad ^ grs) << 4);
    u32x4 rk = *(const u32x4*)kg, rv = *(const u32x4*)vg;
    *(u32x4*)(lds + kw) = rk; *(u32x4*)(lds + vw) = rv;
    __syncthreads();
#pragma unroll 1
    for (int kb = 0; kb < kend; kb += 32) {
        char* cur = lds + ((kb >> 5) & 1) * 8192;
        char* nxt = lds + (((kb >> 5) + 1) & 1) * 8192;
        const bool more = kb + 32 < kend;
        if (more) { rk = *(const u32x4*)(kg + (size_t)(kb + 32) * 32); rv = *(const u32x4*)(vg + (size_t)((kb + 32) >> 5) * 2048); }
        bf16x8 kf[2][2], vf[4];
#pragma unroll
        for (int m = 0; m < 2; ++m)
#pragma unroll
            for (int kt = 0; kt < 2; ++kt) kf[m][kt] = *(const bf16x8*)(cur + m * 2048 + kt * 1024 + fo);
#pragma unroll
        for (int dt = 0; dt < 4; ++dt) vf[dt] = *(const bf16x8*)(cur + 4096 + dt * 1024 + fo);
#pragma unroll
        for (int m = 0; m < 2; ++m)
#pragma unroll
            for (int qt = 0; qt < 2; ++qt) {
                f32x4 s[2];
#pragma unroll
                for (int kt = 0; kt < 2; ++kt) s[kt] = mfma16(kf[m][kt], qf[m][qt], (f32x4){0.f, 0.f, 0.f, 0.f});
                float ps = 0.f;
#pragma unroll
                for (int kt = 0; kt < 2; ++kt)
#pragma unroll
                    for (int j = 0; j < 4; ++j) { const float pv = __builtin_amdgcn_exp2f(s[kt][j] * c1 - c2); s[kt][j] = pv; ps += pv; }
                ls[m][qt] += ps;
                const bf16x8 pf = pack8(s[0], s[1]);
#pragma unroll
                for (int dt = 0; dt < 4; ++dt) acc[m][qt][dt] = mfma16(vf[dt], pf, acc[m][qt][dt]);
            }
        if (more) { *(u32x4*)(nxt + kw) = rk; *(u32x4*)(nxt + vw) = rv; }
        __syncthreads();
    }
    const float* sub = p.a_subln + layer * 64;
#pragma unroll
    for (int qt = 0; qt < 2; ++qt) {
        float l0 = ls[0][qt], l1 = ls[1][qt];
        l0 += __shfl_xor(l0, 16); l0 += __shfl_xor(l0, 32); l1 += __shfl_xor(l1, 16); l1 += __shfl_xor(l1, 32);
        const float i0 = 1.f / l0, i1 = lam / l1;
        f32x4 o[4]; float ss = 0.f;
#pragma unroll
        for (int dt = 0; dt < 4; ++dt) { o[dt] = acc[0][qt][dt] * i0 - acc[1][qt][dt] * i1; ss += o[dt][0] * o[dt][0] + o[dt][1] * o[dt][1] + o[dt][2] * o[dt][2] + o[dt][3] * o[dt][3]; }
        ss += __shfl_xor(ss, 16); ss += __shfl_xor(ss, 32);
        const float r = rsqrtf(ss * (1.f / 64.f) + EPS) * (1.f - lam_init);
        const size_t row = (size_t)b * TB + qt0 + qt * 16 + l15;
#pragma unroll
        for (int dt = 0; dt < 4; ++dt) {
            const int dv = dt * 16 + quad * 4;
            const f32x4 sw = *(const f32x4*)(sub + dv);
            u32x2 ov; ov.x = cvt_pk_bf16(o[dt][0] * r * sw[0], o[dt][1] * r * sw[1]); ov.y = cvt_pk_bf16(o[dt][2] * r * sw[2], o[dt][3] * r * sw[3]);
            *(u32x2*)(Y + row * D + h * 64 + dv) = ov;
        }
    }
}

__device__ __forceinline__ void attnB_item(const Params& p, int layer, int b, int hq, int qt_first, bool lat, char* lds) {
    char* dob = (char*)p.out;
    const bf16_t *QB = (const bf16_t*)(dob + DO_QB), *KB = (const bf16_t*)(dob + DO_KB), *VBT = (const bf16_t*)(dob + DO_VBT);
    bf16_t* Y = (bf16_t*)(p.ws + OFF_HN);
    const int tidb = opaque_tid();
    const int lane = tidb & 63, w = tidb >> 6, l15 = lane & 15, quad = lane >> 4, kvh = hq / 3;
    const float mq = wave_max(fabsf(p.b_qnorm[layer * 64 + lane])), mk = wave_max(fabsf(p.b_knorm[layer * 64 + lane]));
    const float scale = 0.125f, c1 = scale * LOG2E, c2 = 64.f * mq * mk * scale * LOG2E;
    const int qt0 = qt_first + w * 32;
    f32x4 acc[2][4]; float ls[2] = {0.f, 0.f};
#pragma unroll
    for (int qt = 0; qt < 2; ++qt)
#pragma unroll
        for (int dt = 0; dt < 4; ++dt) acc[qt][dt] = (f32x4){0.f, 0.f, 0.f, 0.f};
    const bf16_t* Qp = QB + (size_t)(b * 6 + hq) * TB * 64;
    const bf16_t* Kp = KB + (size_t)(b * 2 + kvh) * TB * 64;
    const bf16_t* Vp = VBT + (size_t)(b * 2 + kvh) * 64 * TB;
    int lo = 0, nst = 8;
    if (lat) {
        lo = qt_first - 128; if (lo < TC) lo = TC;
        int hi = qt_first + 128 + 128; if (hi > TB) hi = TB;
        lo &= ~31; hi = (hi + 31) & ~31;
        nst += (hi - lo) >> 5;
    }
    bf16x8 qf[2][2];
#pragma unroll
    for (int qt = 0; qt < 2; ++qt)
#pragma unroll
        for (int ks = 0; ks < 2; ++ks) qf[qt][ks] = ld8(Qp + (size_t)(qt0 + qt * 16 + l15) * 64 + ks * 32 + quad * 8);
    const int skey = tidb >> 3, skc = tidb & 7;
    const int sdv = tidb >> 2, svc = tidb & 3;
    const int gsw = (tidb >> 4) & 3, gws = (gsw == 0) ? 0 : (gsw == 1) ? 2 : (gsw == 2) ? 3 : 1;
    const bf16_t* kg = Kp + (size_t)skey * 64 + skc * 8;
    const bf16_t* vg = Vp + (size_t)sdv * 32 + svc * 8;
    const int kw = skey * 128 + ((skc ^ ((skey >> 1) & 7)) << 4);
    const int vw = 4096 + sdv * 64 + ((svc ^ gws) << 4);
    const int gsr = (l15 >> 2) & 3, grs = (gsr == 0) ? 0 : (gsr == 1) ? 2 : (gsr == 2) ? 3 : 1;
    const int kfo = l15 * 128;
    const int vfo = 4096 + l15 * 64 + ((quad ^ grs) << 4);
    u32x4 rk = *(const u32x4*)kg, rv = *(const u32x4*)vg;
    *(u32x4*)(lds + kw) = rk; *(u32x4*)(lds + vw) = rv;
    __syncthreads();
#pragma unroll 1
    for (int st = 0; st < nst; ++st) {
        const int kb = (st < 8) ? st * 32 : lo + (st - 8) * 32;
        const bool band = st >= 8;
        char* cur = lds + (st & 1) * 8192;
        char* nxt = lds + ((st + 1) & 1) * 8192;
        const bool more = st + 1 < nst;
        if (more) { const int kn = (st + 1 < 8) ? (st + 1) * 32 : lo + (st + 1 - 8) * 32; rk = *(const u32x4*)(kg + (size_t)kn * 64); rv = *(const u32x4*)(vg + (size_t)(kn >> 5) * 2048); }
        bf16x8 kf[2][2], vf[4];
#pragma unroll
        for (int kt = 0; kt < 2; ++kt)
#pragma unroll
            for (int ks = 0; ks < 2; ++ks) kf[kt][ks] = *(const bf16x8*)(cur + kt * 2048 + kfo + (((ks * 4 + quad) ^ (l15 >> 1)) << 4));
#pragma unroll
        for (int dt = 0; dt < 4; ++dt) vf[dt] = *(const bf16x8*)(cur + vfo + dt * 1024);
#pragma unroll
        for (int qt = 0; qt < 2; ++qt) {
            f32x4 s[2];
#pragma unroll
            for (int kt = 0; kt < 2; ++kt) {
                s[kt] = (f32x4){0.f, 0.f, 0.f, 0.f};
#pragma unroll
                for (int ks = 0; ks < 2; ++ks) s[kt] = mfma16(kf[kt][ks], qf[qt][ks], s[kt]);
            }
            float ps = 0.f;
#pragma unroll
            for (int kt = 0; kt < 2; ++kt)
#pragma unroll
                for (int j = 0; j < 4; ++j) {
                    float pv = __builtin_amdgcn_exp2f(s[kt][j] * c1 - c2);
                    if (band) {
                        const int dd = (qt0 + qt * 16 + l15) - (kb + kt * 16 + quad * 4 + j);
                        if (dd > 128 || dd < -128) pv = 0.f;
                    }
                    s[kt][j] = pv; ps += pv;
                }
            ls[qt] += ps;
            const bf16x8 pf = pack8(s[0], s[1]);
#pragma unroll
            for (int dt = 0; dt < 4; ++dt) acc[qt][dt] = mfma16(vf[dt], pf, acc[qt][dt]);
        }
        if (more) { *(u32x4*)(nxt + kw) = rk; *(u32x4*)(nxt + vw) = rv; }
        __syncthreads();
    }
    const float snk = exp2f(p.b_sink[layer * 6 + hq] * LOG2E - c2);
#pragma unroll
    for (int qt = 0; qt < 2; ++qt) {
        float l0 = ls[qt]; l0 += __shfl_xor(l0, 16); l0 += __shfl_xor(l0, 32);
        const float inv = 1.f / (l0 + snk);
        const size_t row = (size_t)b * TB + qt0 + qt * 16 + l15;
#pragma unroll
        for (int dt = 0; dt < 4; ++dt) {
            const int dv = dt * 16 + quad * 4;
            u32x2 ov; ov.x = cvt_pk_bf16(acc[qt][dt][0] * inv, acc[qt][dt][1] * inv); ov.y = cvt_pk_bf16(acc[qt][dt][2] * inv, acc[qt][dt][3] * inv);
            *(u32x2*)(Y + row * D + 256 + hq * 64 + dv) = ov;
        }
    }
}

__device__ __forceinline__ void chunk_prep(const Params& p, int b, int c, int h, char* lds) {
    float* As = (float*)lds;
    float* Gs = As + 2 * 64 * 68;
    float* Bs = Gs + 128;
    bf16_t* KS = (bf16_t*)(lds + 35840);
    bf16_t* VS = KS + 4096;
    const bf16_t *QC = (const bf16_t*)(p.ws + OFF_QC), *KC = (const bf16_t*)(p.ws + OFF_KC), *VC = (const bf16_t*)(p.ws + OFF_VC);
    const float *G = (const float*)(p.ws + OFF_G), *BETA = (const float*)(p.ws + OFF_BETA);
    bf16_t* REC = (bf16_t*)(p.ws + OFF_BIG);
    float *EG = (float*)(p.ws + OFF_EG), *GL = (float*)(p.ws + OFF_GL);
    const int tid = opaque_tid(), lane = tid & 63, w = tid >> 6, l15 = lane & 15, quad = lane >> 4;
    const size_t row0 = (size_t)b * TB + c * 64;
    const size_t rec0 = ((size_t)(b * 36 + c) * 6 + h) * 2;
    {
        const int r = tid >> 3, ch = tid & 7;
        const u32x4 k0 = *(const u32x4*)(KC + (row0 + r) * 384 + h * 64 + ch * 8), k1 = *(const u32x4*)(KC + (row0 + r + 32) * 384 + h * 64 + ch * 8);
        const u32x4 v0 = *(const u32x4*)(VC + (row0 + r) * 384 + h * 64 + ch * 8), v1 = *(const u32x4*)(VC + (row0 + r + 32) * 384 + h * 64 + ch * 8);
        *(u32x4*)(KS + r * 64 + ch * 8) = k0; *(u32x4*)(KS + (r + 32) * 64 + ch * 8) = k1;
        *(u32x4*)(VS + r * 64 + ch * 8) = v0; *(u32x4*)(VS + (r + 32) * 64 + ch * 8) = v1;
    }
    if (w < 2) {
        const int d = w, tok = d ? 63 - lane : lane;
        float g = G[(row0 + tok) * 12 + d * 6 + h];
#pragma unroll
        for (int off = 1; off < 64; off <<= 1) { const float n = __shfl_up(g, off); if (lane >= off) g += n; }
        Gs[d * 64 + lane] = g; Bs[d * 64 + lane] = BETA[(row0 + tok) * 12 + d * 6 + h];
    }
    f32x4 kk[4], qk[4];
    {
        bf16x8 kj[4][2], ki[2], qi[2];
#pragma unroll
        for (int jt = 0; jt < 4; ++jt)
#pragma unroll
            for (int ks = 0; ks < 2; ++ks) kj[jt][ks] = ld8(KC + (row0 + jt * 16 + l15) * 384 + h * 64 + ks * 32 + quad * 8);
#pragma unroll
        for (int ks = 0; ks < 2; ++ks) { ki[ks] = ld8(KC + (row0 + w * 16 + l15) * 384 + h * 64 + ks * 32 + quad * 8); qi[ks] = ld8(QC + (row0 + w * 16 + l15) * 384 + h * 64 + ks * 32 + quad * 8); }
#pragma unroll
        for (int jt = 0; jt < 4; ++jt) {
            kk[jt] = (f32x4){0.f, 0.f, 0.f, 0.f}; qk[jt] = (f32x4){0.f, 0.f, 0.f, 0.f};
#pragma unroll
            for (int ks = 0; ks < 2; ++ks) { kk[jt] = mfma16(ki[ks], kj[jt][ks], kk[jt]); qk[jt] = mfma16(qi[ks], kj[jt][ks], qk[jt]); }
        }
    }
    __syncthreads();
    {
        bf16_t* R0 = REC + rec0 * 16384 + 8192;
        bf16_t* R1 = REC + (rec0 + 1) * 16384 + 8192;
#pragma unroll
        for (int jt = 0; jt < 4; ++jt)
#pragma unroll
            for (int r = 0; r < 4; ++r) {
                const int i = w * 16 + quad * 4 + r, j = jt * 16 + l15;
                const float kv = kk[jt][r], qv = qk[jt][r];
                {
                    const float dec = (i >= j) ? __expf(Gs[i] - Gs[j]) : 0.f;
                    if (i > j) As[i * 68 + j] = Bs[i] * kv * dec;
                    R0[i * 64 + kpos(j)] = f2bf(qv * dec);
                }
                {
                    const int ip = 63 - i, jp = 63 - j;
                    const float dec = (ip >= jp) ? __expf(Gs[64 + ip] - Gs[64 + jp]) : 0.f;
                    if (ip > jp) As[64 * 68 + ip * 68 + jp] = Bs[64 + ip] * kv * dec;
                    R1[ip * 64 + kpos(jp)] = f2bf(qv * dec);
                }
            }
    }
    __syncthreads();
    {
        const int d = (tid >> 6) & 1, cc = tid & 63;
        const float* Ad = As + d * 64 * 68;
        const float* Gd = Gs + d * 64;
        const float* Bd = Bs + d * 64;
        bf16_t* R = REC + (rec0 + d) * 16384;
        if (tid < 128) {
            f32x2_t x[64];
            const bf16_t* vp = VS + cc; const bf16_t* kp = KS + kpos(cc);
#pragma unroll
            for (int ip = 0; ip < 64; ++ip) {
                const int tok = d ? 63 - ip : ip;
                const float bb = Bd[ip];
                f32x2_t s4[4] = {(f32x2_t){bb * bf2f(vp[tok * 64]), bb * __expf(Gd[ip]) * bf2f(kp[tok * 64])}, (f32x2_t){0.f, 0.f}, (f32x2_t){0.f, 0.f}, (f32x2_t){0.f, 0.f}};
#pragma unroll
                for (int j4 = 0; j4 < (ip + 3) / 4; ++j4) {
                    const f32x4 a = *(const f32x4*)(Ad + ip * 68 + j4 * 4);
#pragma unroll
                    for (int q = 0; q < 4; ++q) if (j4 * 4 + q < ip) s4[q] -= a[q] * x[j4 * 4 + q];
                }
                x[ip] = (s4[0] + s4[1]) + (s4[2] + s4[3]);
                if ((ip & 3) == 3) asm volatile("" ::: "memory");
            }
#pragma unroll
            for (int i8 = 0; i8 < 8; ++i8) {
                u32x4 o; o.x = cvt_pk_bf16(x[i8 * 8].x, x[i8 * 8 + 1].x); o.y = cvt_pk_bf16(x[i8 * 8 + 2].x, x[i8 * 8 + 3].x); o.z = cvt_pk_bf16(x[i8 * 8 + 4].x, x[i8 * 8 + 5].x); o.w = cvt_pk_bf16(x[i8 * 8 + 6].x, x[i8 * 8 + 7].x);
                *(u32x4*)(R + cc * 64 + i8 * 8) = o;
            }
            { const int wp = kpos(cc);
#pragma unroll
              for (int ip = 0; ip < 64; ++ip) R[4096 + ip * 64 + wp] = f2bf(-x[ip].y); }
        } else {
            const float gl = Gd[63];
            const bf16_t* kcol = KS + kpos(cc);
#pragma unroll 2
            for (int i8 = 0; i8 < 8; ++i8) {
                float kv[8];
#pragma unroll
                for (int q = 0; q < 8; ++q) { const int ip = (i8 >> 2) * 32 + (q >> 2) * 16 + (i8 & 3) * 4 + (q & 3), tok = d ? 63 - ip : ip; kv[q] = bf2f(kcol[tok * 64]) * __expf(gl - Gd[ip]); }
                u32x4 o; o.x = cvt_pk_bf16(kv[0], kv[1]); o.y = cvt_pk_bf16(kv[2], kv[3]); o.z = cvt_pk_bf16(kv[4], kv[5]); o.w = cvt_pk_bf16(kv[6], kv[7]);
                *(u32x4*)(R + 12288 + cc * 64 + i8 * 8) = o;
            }
            const float eg = __expf(Gd[cc]);
            EG[(rec0 + d) * 64 + cc] = eg;
            if (cc == 63) GL[rec0 + d] = eg;
        }
    }
    __syncthreads();
}

__device__ __forceinline__ void scan_chain(const Params& p, int b, int h, int d, bool need_ctx, char* lds) {
    const bf16_t* REC = (const bf16_t*)(p.ws + OFF_BIG);
    const bf16_t* QC = (const bf16_t*)(p.ws + OFF_QC);
    const float *EG = (const float*)(p.ws + OFF_EG), *GL = (const float*)(p.ws + OFF_GL);
    bf16_t* O = (bf16_t*)(p.ws + (d ? OFF_VC : OFF_KC));
    const int tids = opaque_tid();
    const int lane = tids & 63, w = tids >> 6, l15 = lane & 15, quad = lane >> 4;
    const int srow = tids >> 3, sswz = ((tids & 7) ^ ((tids >> 4) & 7)) << 4;
    const int fsw = l15 >> 1;
    float* egs = (float*)(lds + 40960);
    f32x4 S[4];
#pragma unroll
    for (int kt = 0; kt < 4; ++kt) S[kt] = (f32x4){0.f, 0.f, 0.f, 0.f};
    u32x4 st[10]; float eg_n = 0.f, gl_n = 0.f, gl_c = 0.f;
#define SCAN_ISSUE(STEP) do { \
        const int c_ = d ? ((STEP) < 4 ? 3 - (STEP) : 39 - (STEP)) : (STEP); \
        const size_t rec_ = ((size_t)(b * 36 + c_) * 6 + h) * 2 + d; \
        const bf16_t* R_ = REC + rec_ * 16384 + (size_t)tids * 8; \
        _Pragma("unroll") for (int i = 0; i < 8; ++i) st[i] = *(const u32x4*)(R_ + i * 2048); \
        const size_t row0_ = (size_t)b * TB + c_ * 64; \
        _Pragma("unroll") for (int i = 0; i < 2; ++i) { const int r_ = srow + 32 * i, tok_ = d ? 63 - r_ : r_; st[8 + i] = *(const u32x4*)(QC + (row0_ + tok_) * 384 + h * 64 + (tids & 7) * 8); } \
        if (tids < 64) eg_n = EG[rec_ * 64 + tids]; \
        gl_n = GL[rec_]; } while (0)
#define SCAN_STORE() do { \
        _Pragma("unroll") for (int i = 0; i < 8; ++i) *(u32x4*)(lds + (i >> 1) * 8192 + (srow + 32 * (i & 1)) * 128 + sswz) = st[i]; \
        _Pragma("unroll") for (int i = 0; i < 2; ++i) *(u32x4*)(lds + 4 * 8192 + (srow + 32 * i) * 128 + sswz) = st[8 + i]; \
        if (tids < 64) egs[tids] = eg_n; \
        gl_c = gl_n; } while (0)
#define SCAN_FRAG(M, T, KS) (*(const bf16x8*)(lds + (M) * 8192 + ((T) * 16 + l15) * 128 + ((((KS) * 4 + quad) ^ fsw) << 4)))
    SCAN_ISSUE(0);
    SCAN_STORE();
    __syncthreads();
#pragma unroll 1
    for (int step = 0; step < 36; ++step) {
        const int c = d ? (step < 4 ? 3 - step : 39 - step) : step;
        const size_t row0 = (size_t)b * TB + c * 64;
        if (step + 1 < 36) SCAN_ISSUE(step + 1);
        const float gl = gl_c;
        bf16x8 Sb[2], Vb[2];
        Sb[0] = pack8(S[0], S[1]); Sb[1] = pack8(S[2], S[3]);
        f32x4 vn[4];
#pragma unroll
        for (int lt = 0; lt < 4; ++lt) {
            const u32x2 ur = *(const u32x2*)(lds + (16 * w + l15) * 128 + (((lt * 2 + (quad >> 1)) ^ fsw) << 4) + (quad & 1) * 8);
            vn[lt] = (f32x4){bflo(ur.x), bfhi(ur.x), bflo(ur.y), bfhi(ur.y)};
#pragma unroll
            for (int ks = 0; ks < 2; ++ks) vn[lt] = mfma16(SCAN_FRAG(1, lt, ks), Sb[ks], vn[lt]);
        }
        Vb[0] = pack8(vn[0], vn[1]); Vb[1] = pack8(vn[2], vn[3]);
        f32x4 o[4];
#pragma unroll
        for (int lt = 0; lt < 4; ++lt) {
            const float eg = egs[lt * 16 + l15];
            o[lt] = (f32x4){0.f, 0.f, 0.f, 0.f};
#pragma unroll
            for (int ks = 0; ks < 2; ++ks) {
                const u32x4 qa = __builtin_bit_cast(u32x4, SCAN_FRAG(4, lt, ks));
                u32x4 qq; qq.x = cvt_pk_bf16(bflo(qa.x) * eg, bfhi(qa.x) * eg); qq.y = cvt_pk_bf16(bflo(qa.y) * eg, bfhi(qa.y) * eg);
                qq.z = cvt_pk_bf16(bflo(qa.z) * eg, bfhi(qa.z) * eg); qq.w = cvt_pk_bf16(bflo(qa.w) * eg, bfhi(qa.w) * eg);
                o[lt] = mfma16(__builtin_bit_cast(bf16x8, qq), Sb[ks], o[lt]);
            }
#pragma unroll
            for (int ls = 0; ls < 2; ++ls) o[lt] = mfma16(SCAN_FRAG(2, lt, ls), Vb[ls], o[lt]);
        }
#pragma unroll
        for (int kt = 0; kt < 4; ++kt) {
            S[kt] = S[kt] * gl;
#pragma unroll
            for (int ls = 0; ls < 2; ++ls) S[kt] = mfma16(SCAN_FRAG(3, kt, ls), Vb[ls], S[kt]);
        }
        if (need_ctx || c >= 4) {
#pragma unroll
            for (int lt = 0; lt < 4; ++lt)
#pragma unroll
                for (int r = 0; r < 4; ++r) { const int L = lt * 16 + quad * 4 + r, tok = d ? 63 - L : L; O[(row0 + tok) * 384 + h * 64 + 16 * w + l15] = f2bf(o[lt][r]); }
        }
        __syncthreads();
        if (step + 1 < 36) SCAN_STORE();
        __syncthreads();
    }
#undef SCAN_ISSUE
#undef SCAN_STORE
#undef SCAN_FRAG
}

__device__ __forceinline__ void cout_phase(const Params& p, int layer, bool need_ctx) {
    const bf16_t *O0 = (const bf16_t*)(p.ws + OFF_KC), *O1 = (const bf16_t*)(p.ws + OFF_VC);
    bf16_t* Y = (bf16_t*)(p.ws + OFF_HN);
    const int tidc = opaque_tid();
    const int lane = tidc & 63, gw = blockIdx.x * 4 + (tidc >> 6), nw = gridDim.x * 4;
    const float wn = p.c_onorm[layer * 64 + lane];
    for (int rb = gw * 9; rb < M; rb += nw * 9) {
#pragma unroll 1
        for (int g3 = 0; g3 < 3; ++g3) {
            unsigned short o0[3][6], o1[3][6], gzr[3][6]; bool ok[3];
#pragma unroll
            for (int u = 0; u < 3; ++u) {
                const int row = rb + g3 * 3 + u;
                const int t = row % TB;
                ok[u] = (row < M) && (need_ctx || t >= TC);
                if (ok[u]) {
#pragma unroll
                    for (int hh = 0; hh < 6; ++hh) {
                        const size_t oi = (size_t)row * 384 + hh * 64 + lane;
                        o0[u][hh] = O0[oi]; o1[u][hh] = O1[oi]; gzr[u][hh] = Y[(size_t)row * D + 640 + hh * 64 + lane];
                    }
                }
            }
            asm volatile("" ::: "memory");
#pragma unroll
            for (int u = 0; u < 3; ++u) {
                if (!ok[u]) continue;
                const int row = rb + g3 * 3 + u;
#pragma unroll
                for (int hh = 0; hh < 6; ++hh) {
                    const float o = bf2f(o0[u][hh]) + bf2f(o1[u][hh]);
                    const float ss = wave_sum(o * o);
                    Y[(size_t)row * D + 640 + hh * 64 + lane] = f2bf(o * rsqrtf(ss * (1.f / 64.f) + EPS) * wn * bf2f(gzr[u][hh]));
                }
            }
        }
    }
}


#define DBG_NAN 0
__device__ __forceinline__ void dbg_scan(const void* ptr, size_t nbytes, bool is_bf16, unsigned* flag, unsigned code) {
    const u32x4* q = (const u32x4*)ptr; const size_t n = nbytes / 16;
    bool bad = false;
    for (size_t i = (size_t)blockIdx.x * 256 + threadIdx.x; i < n; i += (size_t)gridDim.x * 256) {
        const u32x4 v = q[i];
#pragma unroll
        for (int k = 0; k < 4; ++k) {
            const unsigned u = v[k];
            if (is_bf16) { if ((u & 0x7F80u) > (140u << 7) || (u & 0x7F800000u) > (140u << 23)) bad = true; }
            else if ((u & 0x7F800000u) > (140u << 23)) bad = true;
        }
    }
    if (bad) atomicMin(flag, code);
}

#define XB_TMO      128
#define XB_XCNT(j)  (256  + 64 * (j))
#define XB_XSUB(j)  (1280 + 64 * (j))
#define XB_XGEN(j)  (2304 + 64 * (j))
#define XB_TOP      3328
#define XB_TOPGEN   3392
#define XB_SPIN_CAP (1u << 21)
#define LAS __attribute__((address_space(3)))
__device__ __forceinline__ unsigned xb_ld(unsigned* p)              { return __hip_atomic_load(p, __ATOMIC_RELAXED, __HIP_MEMORY_SCOPE_AGENT); }
__device__ __forceinline__ unsigned xb_add(unsigned* p, unsigned v) { return __hip_atomic_fetch_add(p, v, __ATOMIC_RELAXED, __HIP_MEMORY_SCOPE_AGENT); }
__device__ __forceinline__ unsigned xb_xcc_id() { return (unsigned)__builtin_amdgcn_s_getreg((3 << 11) | 20) & 0xFu; }
#define XB_SPIN(cond, bar) do { unsigned _sp = 0; while (cond) { __builtin_amdgcn_s_sleep(1); \
    if ((++_sp & 255u) == 0u) { if (xb_ld(&(bar)[XB_TMO])) break; if (_sp > XB_SPIN_CAP) { atomicAdd(&(bar)[XB_TMO], 1u); break; } } } } while (0)
__device__ __forceinline__ void xcd_barrier_complete(unsigned* bar, unsigned x, unsigned& nloc, unsigned& nx) {
    const unsigned G = gridDim.x * gridDim.y * gridDim.z;
    unsigned sum, cnt, mine, sp = 0u;
    for (;;) {
        sum = 0u; cnt = 0u; mine = 0u;
#pragma unroll
        for (unsigned j = 0; j < 16; ++j) { const unsigned c = xb_ld(&bar[XB_XCNT(j)]); sum += c; cnt += (c > 0u) ? 1u : 0u; mine = (j == x) ? c : mine; }
        if (sum == G) break;
        __builtin_amdgcn_s_sleep(1);
        if ((++sp & 255u) == 0u) { if (xb_ld(&bar[XB_TMO])) break; if (sp > XB_SPIN_CAP) { atomicAdd(&bar[XB_TMO], 1u); break; } }
    }
    nloc = mine > 0u ? mine : 1u; nx = cnt > 0u ? cnt : 1u;
}
__device__ __forceinline__ void xcd_barrier(unsigned* bar, volatile LAS unsigned* st) {
    asm volatile("s_waitcnt vmcnt(0)" ::: "memory");
    __syncthreads();
    if (threadIdx.x == 0) {
        const unsigned x = xb_xcc_id();
        __builtin_amdgcn_s_waitcnt(0);
        unsigned nloc = st[0], nx = st[1];
        if (nloc == 0u) { xcd_barrier_complete(bar, x, nloc, nx); st[0] = nloc; st[1] = nx; }
        const unsigned old = xb_add(&bar[XB_XSUB(x)], 1u);
        const unsigned gen = old / nloc;
        if (old + 1u == (gen + 1u) * nloc) {
            __builtin_amdgcn_fence(__ATOMIC_RELEASE, "agent");
            asm volatile("s_waitcnt vmcnt(0)" ::: "memory");
            const unsigned og = xb_add(&bar[XB_TOP], 1u);
            const unsigned tg = og / nx;
            if (og + 1u == (tg + 1u) * nx) xb_add(&bar[XB_TOPGEN], 1u);
            else XB_SPIN(xb_ld(&bar[XB_TOPGEN]) == tg, bar);
            __builtin_amdgcn_fence(__ATOMIC_ACQUIRE, "agent");
            xb_add(&bar[XB_XGEN(x)], 1u);
            asm volatile("s_waitcnt vmcnt(0)" ::: "memory");
        } else {
            XB_SPIN(xb_ld(&bar[XB_XGEN(x)]) == gen, bar);
            __builtin_amdgcn_fence(__ATOMIC_ACQUIRE, "agent");
            asm volatile("s_waitcnt vmcnt(0)" ::: "memory");
        }
    }
    __syncthreads();
}

__device__ __forceinline__ void conv_jobs(const Params& p, int set, int first, int stride, char* lds) {
    bf16_t* Wb = (bf16_t*)(p.ws + OFF_W);
    const int j0 = (set == 2) ? 3 : 0, j1 = (set == 1) ? 3 : 6;
    const size_t lo = (set == 0) ? 0 : 1;
    for (int j = j0; j < j1; ++j) {
        const float* W; bf16_t* Wt; int K, N, Npad, mode;
        switch (j) {
            case 0: W = p.ffn1_w1 + lo * 1024 * 5632; Wt = Wb + WO_W1A; K = 1024; N = 5632; Npad = 5632; mode = 1; break;
            case 1: W = p.ffn1_w2 + lo * 2816 * 1024; Wt = Wb + WO_W2A; K = 2816; N = 1024; Npad = 1024; mode = 0; break;
            case 2: W = p.w_in + lo * 1024 * NIN; Wt = Wb + WO_WIN; K = 1024; N = NIN; Npad = NINP; mode = 0; break;
            case 3: W = p.w_out + lo * 1024 * 1024; Wt = Wb + WO_WOUT; K = 1024; N = 1024; Npad = 1024; mode = 0; break;
            case 4: W = p.ffn2_w1 + lo * 1024 * 5632; Wt = Wb + WO_W1B; K = 1024; N = 5632; Npad = 5632; mode = 1; break;
            default: W = p.ffn2_w2 + lo * 2816 * 1024; Wt = Wb + WO_W2B; K = 2816; N = 1024; Npad = 1024; mode = 0; break;
        }
        const int nt = (K >> 6) * (Npad >> 7);
#pragma unroll 1
        for (int t = first; t < nt; t += stride) convert_tile(W, K, N, Wt, mode, t, lds);
    }
}

__global__ void __launch_bounds__(256, 2) fwd_megakernel(Params p) {
    cg::grid_group grid = cg::this_grid();
    __shared__ __attribute__((aligned(16))) char lds[65536];
    volatile int& s_item = *(volatile int*)(lds + 65024);
    __shared__ uint4 xb_words;
    if (threadIdx.x == 0) { xb_words = make_uint4(0u, 0u, 0u, 0u); (void)xb_add((unsigned*)(p.ws + OFF_BAR) + XB_XCNT(xb_xcc_id()), 1u); }
    __syncthreads();

#pragma unroll 1
    for (int st = -1; st < 26; ++st) {
        const int layer = (st < 13) ? 0 : 1, s = (st < 0) ? -1 : st - layer * 13;
        const bool last = layer == 1, need_ctx = !last;
        bf16_t* Wb = (bf16_t*)(p.ws + OFF_W);
        float* H = (float*)(p.ws + OFF_H);
        bf16_t* HN = (bf16_t*)(p.ws + OFF_HN);
        bf16_t* BIG = (bf16_t*)(p.ws + OFF_BIG);
        const float* modL = (const float*)(p.ws + OFF_MOD) + (size_t)layer * 9 * 9216;
        switch (s) {
        case -1: {
            unsigned* CTR = (unsigned*)(p.ws + OFF_CTR);
            const int tid = opaque_tid();
#pragma unroll 1
            for (int it = blockIdx.x; it < 288; it += gridDim.x) mod_tile(p, it, lds);
            conv_jobs(p, 0, blockIdx.x, gridDim.x, lds);
            for (size_t i = (size_t)blockIdx.x * 256 + tid; i < (size_t)M * 256; i += (size_t)gridDim.x * 256) {
                const int row = (int)(i >> 8), c4 = (int)(i & 255), b = row / TB, t = row - b * TB;
                const float* src = (t < TC) ? p.ctx + ((size_t)b * TC + t) * D : p.x + ((size_t)b * TL + (t - TC)) * D;
                *(f32x4*)(H + (size_t)row * D + c4 * 4) = *(const f32x4*)(src + c4 * 4);
            }
        } break;
        case 0: case 3: case 10:
            norm_phase(p, layer, s == 10 ? 6 : s, last && s == 10);
            break;
        case 1: case 11: {
            EpiArgs e{}; e.obf = BIG;
            gemm256_phase<0>(HN, Wb + (s == 1 ? WO_W1A : WO_W1B), 1024, 44, last && s == 11, e, lds);
        } break;
        case 2: case 9: case 12: {
            EpiArgs e{}; e.H = H; e.gate = modL + (s == 2 ? 2 : (s == 9 ? 5 : 8)) * 1024; e.gscale = (s == 9) ? 1.0f : 0.5f;
            e.outp = (last && s == 12) ? p.out : nullptr;
            gemm_phase<1>(s == 9 ? HN : BIG, Wb + (s == 2 ? WO_W2A : (s == 9 ? WO_WOUT : WO_W2B)), s == 9 ? 1024 : 2816, 8, last && s >= 9, e, lds);
        } break;
        case 4: {
            EpiArgs e{}; e.obf = BIG; e.ldo = NINP;
            gemm256_phase<2>(HN, Wb + WO_WIN, 1024, 24, false, e, lds);
        } break;
        case 5:
            prep_phase(p, layer, lds);
            break;
        case 6: {
            unsigned* CTR = (unsigned*)(p.ws + OFF_CTR);
#pragma unroll 1
            for (;;) {
                if (threadIdx.x == 0) s_item = (int)atomicAdd(&CTR[layer], 1u);
                __syncthreads();
                const int it = s_item;
                __syncthreads();
                if (it >= 1728) break;
                const int h = it % 6, c = (it / 6) % 36, b = it / 216;
                chunk_prep(p, b, c, h, lds);
            }
        } break;
        case 7:
            if (blockIdx.x < 96) { const int d = blockIdx.x & 1, h = (blockIdx.x >> 1) % 6, b = blockIdx.x / 12; __builtin_amdgcn_s_setprio(3); scan_chain(p, b, h, d, need_ctx, lds); __builtin_amdgcn_s_setprio(0); }
            else {
                conv_jobs(p, last ? 2 : 1, blockIdx.x - 96, gridDim.x - 96, lds);
                unsigned* CTR = (unsigned*)(p.ws + OFF_CTR);
                const float lam_init = last ? 0.35550906759f : 0.2f;
                const int nq = 64 + (need_ctx ? 8 : 0);
                const unsigned x0 = xb_xcc_id() & 7u;
#pragma unroll 1
                for (int v = 0; v < 8; ++v) {
                    const int xq = (int)((x0 + v) & 7u);
#pragma unroll 1
                    for (;;) {
                        if (threadIdx.x == 0) s_item = (int)atomicAdd(&CTR[8 + layer * 8 + xq], 1u);
                        __syncthreads();
                        const int q = s_item;
                        __syncthreads();
                        if (q >= nq) break;
                        const bool lat = q < 64; const int j = lat ? q : q - 64;
                        const int bh = xq + 8 * (lat ? (j >> 4) : (j >> 1)), qb = lat ? (j & 15) : (j & 1);
                        attnA_item(p, layer, bh >> 2, bh & 3, lat ? TC + qb * 128 : qb * 128, lat ? TB : TC, lam_init, lds);
                    }
                }
                {
                    const int nBl = 768, e2 = nBl + (need_ctx ? 96 : 0);
#pragma unroll 1
                    for (;;) {
                        if (threadIdx.x == 0) s_item = (int)atomicAdd(&CTR[4 + layer], 1u);
                        __syncthreads();
                        const int it = s_item;
                        __syncthreads();
                        if (it >= e2) break;
                        const bool lat = it < nBl; const int j = lat ? it : it - nBl;
                        const int qb = lat ? (j & 15) : (j & 1), hq = lat ? ((j >> 4) % 6) : ((j >> 1) % 6), b = lat ? (j / 96) : (j / 12);
                        attnB_item(p, layer, b, hq, lat ? TC + qb * 128 : qb * 128, lat, lds);
                    }
                }
            }
            break;
        default:
            cout_phase(p, layer, need_ctx);
            break;
        }
        if (st == -1) grid.sync();
        else if (st != 25) xcd_barrier((unsigned*)(p.ws + OFF_BAR), (volatile LAS unsigned*)&xb_words);
#if DBG_NAN
        {
            unsigned* flag = (unsigned*)(p.ws + OFF_CTR) + 32;
            const unsigned code = (unsigned)(st + 2);
#pragma unroll 1
            for (int q = 0; q < 3; ++q) {
                const void* ptr = nullptr; size_t nb = 0; bool isb = true; unsigned cd = code;
                if (q == 0) {
                    if (s == -1) { ptr = p.ws + OFF_MOD; nb = (size_t)2 * 9 * 9216 * 4; isb = false; }
                    else if (s == 0 || s == 3 || s == 10 || s == 6 || s == 8) { ptr = HN; nb = SZ_HN; }
                    else if (s == 1 || s == 11) { ptr = BIG; nb = (size_t)M * DFF * 2; }
                    else if (s == 2 || s == 9 || (s == 12 && !last)) { ptr = H; nb = SZ_H; isb = false; }
                    else if (s == 4) { ptr = BIG; nb = SZ_BIG; }
                    else if (s == 5) { ptr = p.ws + OFF_QC; nb = 3 * SZ_QC; }
                    else if (s == 7) { ptr = p.out; nb = (size_t)2 * M * 384 * 4; isb = false; }
                } else if (q == 1) {
                    if (s == 5) { ptr = p.out; nb = DO_END; }
                    else if (s == 6) { ptr = BIG; nb = SZ_BIG; cd = code + 30; }
                } else {
                    if (s == 5) { ptr = p.ws + OFF_G; nb = (size_t)M * 24 * 4; isb = false; }
                    else if (s == 6) { ptr = p.ws + OFF_EG; nb = (size_t)NREC * 65 * 4; isb = false; cd = code + 60; }
                }
                if (nb) dbg_scan(ptr, nb, isb, flag, cd);
            }
            if (s == 4) {
                const unsigned idx = blockIdx.x * 256 + threadIdx.x;
                const unsigned row = (idx * 2654435761u) % (unsigned)M, col = (idx * 40503u) % (unsigned)NINP;
                const bf16_t* ar = HN + (size_t)row * D; const bf16_t* br = Wb + WO_WIN + (size_t)col * 1024;
                float dot = 0.f;
                for (int k = 0; k < 1024; ++k) dot += bf2f(ar[k]) * bf2f(br[k]);
                const float cv = bf2f(BIG[(size_t)row * NINP + col]);
                if (!(fabsf(dot - cv) <= 0.05f + 0.02f * fabsf(dot))) atomicMin(flag + 1, 77u);
                if (fabsf(dot) > 100.f) atomicMin(flag + 1, 66u);
            }
            if (s == -1) {
                bf16_t* Wq = (bf16_t*)(p.ws + OFF_W);
#pragma unroll 1
                for (int q = 0; q < 6; ++q) {
                    const size_t o = (q == 0) ? WO_W1A : (q == 1) ? WO_W2A : (q == 2) ? WO_WIN : (q == 3) ? WO_WOUT : (q == 4) ? WO_W1B : WO_W2B;
                    const size_t n = (q == 0 || q == 4) ? E_W1 : (q == 1 || q == 5) ? E_W2 : (q == 2) ? E_WIN : E_WOUT;
                    dbg_scan(Wq + o, n * 2, true, flag + 1, 91u + q);
                }
            }
            grid.sync();
        }
#endif
    }
#if DBG_NAN
    {
        const unsigned f = *((volatile unsigned*)(p.ws + OFF_CTR) + 32);
        const unsigned f2 = *((volatile unsigned*)(p.ws + OFF_CTR) + 33);
        const float codev = (f2 != 9999u) ? 100.f * (float)f2 : ((f == 9999u) ? 0.f : 100.f * (float)f);
        for (size_t i = (size_t)blockIdx.x * 256 + threadIdx.x; i < (size_t)NB * TL * D; i += (size_t)gridDim.x * 256) {
            float v = p.out[i];
            if ((__float_as_uint(v) & 0x7F800000u) == 0x7F800000u) v = 500.f;
            if (codev != 0.f) v = codev;
            p.out[i] = v;
        }
    }
#endif
}

extern "C" void kernel_launch(void* const* d_in, const int* in_sizes, int n_in, void* d_out, int out_size, void* d_ws, size_t ws_size, hipStream_t stream) {
    (void)in_sizes; (void)n_in; (void)out_size;
    static int grid_blocks = 0;
    if (!grid_blocks) {
        int dev = 0, cus = 0, per_cu = 0;
        (void)hipGetDevice(&dev);
        (void)hipDeviceGetAttribute(&cus, hipDeviceAttributeMultiprocessorCount, dev);
        (void)hipOccupancyMaxActiveBlocksPerMultiprocessor(&per_cu, fwd_megakernel, 256, 0);
        if (per_cu > 2) per_cu = 2;
        if (per_cu < 1) per_cu = 1;
        grid_blocks = cus * per_cu;
    }
    if (ws_size < WS_NEED) { fprintf(stderr, "workspace too small: %zu < %zu\n", ws_size, (size_t)WS_NEED); }
    Params p{};
    const float** f = (const float**)&p;
    for (int i = 0; i < 23; ++i) f[i] = (const float*)d_in[i];
    p.out = (float*)d_out; p.ws = (char*)d_ws;
    (void)hipMemsetAsync((char*)d_ws + OFF_CTR, 0, WS_NEED - OFF_CTR, stream);
    void* args[] = {&p};
    hipError_t e = hipLaunchCooperativeKernel((void*)fwd_megakernel, dim3(grid_blocks), dim3(256), args, 0, stream);
    if (e != hipSuccess) fprintf(stderr, "cooperative launch failed: %s (grid %d)\n", hipGetErrorString(e), grid_blocks);
}
```
